# Optimizing an MI355X kernel written in HIP

```python
import math
import jax, jax.numpy as jnp
from jax import lax
import numpy as np

D_MODEL = 1024
BATCH = 32
SEQ = 2048
DEPTH = 2

GRID_W = 64
CTX_LEN = 256

POOL_WIDTH = D_MODEL // 4
POOL_GROUPS = 4
POOL_WINDOWS = (2, 4, 8, 16)
HYENA_WIDTH = D_MODEL // 4
HYENA_SHORT = 3
HYENA_EMB = 33
HYENA_FILTER_ORDER = 64
HYENA_TARGET = 1e-2
HYENA_FAST_PCT = 0.3
HYENA_SLOW_PCT = 1.5
ATTN_WIDTH = D_MODEL // 2
HEAD_DIM = 64
ATTN_HEADS = ATTN_WIDTH // HEAD_DIM
ATTN_KV_HEADS = ATTN_HEADS // 4
ATTN_GROUP = ATTN_HEADS // ATTN_KV_HEADS
KV_WIDTH = ATTN_KV_HEADS * HEAD_DIM
Q_BLOCK = 128
ROPE_THETA = 10000.0
LN_EPS = 1e-6
QK_EPS = 1e-6
DEEPNORM_ALPHA = (2.0 * DEPTH) ** 0.25
DEEPNORM_BETA = (8.0 * DEPTH) ** -0.25

SPLIT_SIZES = (POOL_WIDTH, POOL_WIDTH, 3 * HYENA_WIDTH, HYENA_WIDTH, ATTN_WIDTH, KV_WIDTH, KV_WIDTH, ATTN_WIDTH)
IN_WIDTH = sum(SPLIT_SIZES)
SPLIT_POINTS = tuple(sum(SPLIT_SIZES[:i + 1]) for i in range(len(SPLIT_SIZES) - 1))
K_OFF = SPLIT_POINTS[4]
KV_END = SPLIT_POINTS[6]

kernel_name = "hybrid_pool_hyena_gqa_deepnorm_block"


def _layernorm(x):
    xf = x.astype(jnp.float32)
    mu = jnp.mean(xf, axis=-1, keepdims=True)
    var = jnp.mean(jnp.square(xf - mu), axis=-1, keepdims=True)
    return ((xf - mu) * lax.rsqrt(var + LN_EPS)).astype(x.dtype)


def _rms_head(x, g):
    xf = x.astype(jnp.float32)
    y = xf * lax.rsqrt(jnp.mean(xf * xf, axis=-1, keepdims=True) + QK_EPS) * g.astype(jnp.float32)
    return y.astype(x.dtype)


def _pool_mixer(v, pool_w, pool_scale):
    B, L, _ = v.shape
    gw = POOL_WIDTH // POOL_GROUPS
    vg = v.reshape(B, L, POOL_GROUPS, gw)
    cs = jnp.pad(jnp.cumsum(vg.astype(jnp.float32), axis=1), ((0, 0), (1, 0), (0, 0), (0, 0)))
    t = jnp.arange(L)
    means = []
    for g, w in enumerate(POOL_WINDOWS):
        lo = jnp.clip(t - w // 2, 0, L)
        hi = jnp.clip(t - w // 2 + w, 0, L)
        cnt = (hi - lo).astype(jnp.float32)[None, :, None]
        means.append((cs[:, hi, g] - cs[:, lo, g]) / cnt)
    mean = jnp.stack(means, axis=2).astype(v.dtype)
    y = jnp.einsum('blgc,gcd->blgd', mean - vg, pool_w).reshape(B, L, POOL_WIDTH)
    return y * pool_scale


def _short_conv(u, w, b):
    K, C = w.shape
    y = lax.conv_general_dilated(u, w[:, None, :].astype(u.dtype), window_strides=(1,),
                                 padding=[(K // 2, K // 2)], dimension_numbers=('NWC', 'WIO', 'NWC'),
                                 feature_group_count=C)
    return y + b


def _hyena_kernel(L, w1, b1, freq, w2, b2, w3):
    f32 = jnp.float32
    t = jnp.linspace(0.0, 1.0, L, dtype=f32)[:, None]
    bands = (HYENA_EMB - 1) // 2
    fr = jnp.linspace(1e-4, bands - 1, bands, dtype=f32)
    wpos = 2.0 * math.pi * jnp.arange(L, dtype=f32)[:, None] / L
    z = jnp.concatenate([t, jnp.cos(fr * wpos), -jnp.sin(fr * wpos)], axis=-1)
    fq = freq.astype(f32)
    h = jnp.sin(fq[0] * (z @ w1.astype(f32) + b1.astype(f32)))
    h = jnp.sin(fq[1] * (h @ w2.astype(f32) + b2.astype(f32)))
    h = (h @ w3.astype(f32)).reshape(L, 2, HYENA_WIDTH)
    max_decay = math.log(HYENA_TARGET) / HYENA_FAST_PCT
    min_decay = math.log(HYENA_TARGET) / HYENA_SLOW_PCT
    deltas = jnp.linspace(min_decay, max_decay, HYENA_WIDTH, dtype=f32)
    h = h * jnp.exp(-t * jnp.abs(deltas))[:, None, :]
    h_f, h_b = h[:, 0], h[:, 1]
    k = jnp.concatenate([h_f, jnp.zeros((1, HYENA_WIDTH), f32), h_b[:0:-1]], axis=0)
    return k / jnp.sum(jnp.abs(k), axis=0, keepdims=True)


def _bidir_fftconv(u, k, bias):
    L = u.shape[1]
    uf32 = u.astype(jnp.float32)
    uf = jnp.fft.rfft(uf32, n=2 * L, axis=1)
    kf = jnp.fft.rfft(k, n=2 * L, axis=0)
    y = jnp.fft.irfft(uf * kf[None], n=2 * L, axis=1)[:, :L]
    return (y + uf32 * bias.astype(jnp.float32)).astype(u.dtype)


def _hyena_mixer(uvx, conv_w, conv_b, w1, b1, freq, w2, b2, w3, bias):
    uvx = _short_conv(uvx, conv_w, conv_b)
    x0, x1, v = jnp.split(uvx, 3, axis=-1)
    k = _hyena_kernel(uvx.shape[1], w1, b1, freq, w2, b2, w3)
    return x0 * _bidir_fftconv(x1 * v, k, bias)


def _axial_rope(L):
    rows = L // GRID_W
    row = jnp.repeat(jnp.arange(rows), GRID_W)
    col = jnp.tile(jnp.arange(GRID_W), rows)
    axis_dim = HEAD_DIM // 2
    inv = ROPE_THETA ** (-jnp.arange(0, axis_dim, 2, dtype=jnp.float32) / axis_dim)
    ang = jnp.concatenate([row[:, None] * inv, col[:, None] * inv], axis=-1)
    return jnp.cos(ang), jnp.sin(ang)


def _apply_rope(x, cos, sin):
    B, L, H, D = x.shape
    xr = x.reshape(B, L, H, 2, 2, D // 4)
    a, b = xr[..., 0, :], xr[..., 1, :]
    c = cos.reshape(L, 1, 2, D // 4)
    s = sin.reshape(L, 1, 2, D // 4)
    return jnp.stack([a * c - b * s, a * s + b * c], axis=-2).reshape(B, L, H, D).astype(x.dtype)


def _sdpa(q, k, v):
    s = jnp.einsum('bqhgd,bkhd->bhgqk', q, k).astype(jnp.float32) * (HEAD_DIM ** -0.5)
    p = jax.nn.softmax(s, axis=-1).astype(v.dtype)
    return jnp.einsum('bhgqk,bkhd->bqhgd', p, v)


def _blocked_attention(q, k, v):
    B, L = q.shape[:2]
    nb = L // Q_BLOCK
    qb = jnp.moveaxis(q.reshape(B, nb, Q_BLOCK, *q.shape[2:]), 1, 0)
    ob = lax.map(lambda qq: _sdpa(qq, k, v), qb)
    return jnp.moveaxis(ob, 0, 1).reshape(q.shape)


def _heads_q(t, g, B, L):
    return _rms_head(t.reshape(B, L, ATTN_HEADS, HEAD_DIM), g)


def _heads_kv(t, B, L):
    return t.reshape(B, L, ATTN_KV_HEADS, HEAD_DIM)


def _merge(parts, attn_o, pool_w, pool_scale, hy_args, w_out):
    pool_v, pool_g, hy_u, hy_g, _, _, _, attn_g = parts
    y_pool = _pool_mixer(pool_v, pool_w, pool_scale) * jax.nn.silu(pool_g)
    y_hy = _hyena_mixer(hy_u, *hy_args) * jax.nn.silu(hy_g)
    y_attn = attn_o * jax.nn.silu(attn_g)
    return jnp.concatenate([y_pool, y_hy, y_attn], axis=-1) @ w_out


def setup_inputs(seed: int = 0) -> dict:
    key = jax.random.key(seed)
    ks = jax.random.split(key, 24)
    n = jax.random.normal
    f32 = jnp.float32
    D = D_MODEL
    return {
        "x": n(ks[0], (BATCH, SEQ, D), f32),
        "c": n(ks[1], (BATCH, D), f32),
        "ctx": n(ks[2], (BATCH, CTX_LEN, D), f32),
        "c_ctx": n(ks[3], (D,), f32),
        "w_ada": n(ks[4], (DEPTH, D, 3 * D), f32) * (0.5 * D ** -0.5),
        "b_ada": n(ks[5], (DEPTH, 3 * D), f32) * 0.01,
        "w_in": n(ks[6], (DEPTH, D, IN_WIDTH), f32) * D ** -0.5,
        "pool_w": n(ks[7], (DEPTH, POOL_GROUPS, POOL_WIDTH // POOL_GROUPS, POOL_WIDTH // POOL_GROUPS), f32) * (POOL_WIDTH // POOL_GROUPS) ** -0.5,
        "pool_scale": 1.0 + 0.02 * n(ks[8], (DEPTH, POOL_WIDTH), f32),
        "hy_conv_w": n(ks[9], (DEPTH, HYENA_SHORT, 3 * HYENA_WIDTH), f32) * HYENA_SHORT ** -0.5,
        "hy_conv_b": n(ks[10], (DEPTH, 3 * HYENA_WIDTH), f32) * 0.01,
        "hy_w1": n(ks[11], (DEPTH, HYENA_EMB, HYENA_FILTER_ORDER), f32) * HYENA_EMB ** -0.5,
        "hy_b1": n(ks[12], (DEPTH, HYENA_FILTER_ORDER), f32) * 0.01,
        "hy_freq": 1.0 + 0.02 * n(ks[13], (DEPTH, 2, HYENA_FILTER_ORDER), f32),
        "hy_w2": n(ks[14], (DEPTH, HYENA_FILTER_ORDER, HYENA_FILTER_ORDER), f32) * HYENA_FILTER_ORDER ** -0.5,
        "hy_b2": n(ks[15], (DEPTH, HYENA_FILTER_ORDER), f32) * 0.01,
        "hy_w3": n(ks[16], (DEPTH, HYENA_FILTER_ORDER, 2 * HYENA_WIDTH), f32) * HYENA_FILTER_ORDER ** -0.5,
        "hy_bias": n(ks[17], (DEPTH, HYENA_WIDTH), f32),
        "q_norm": 1.0 + 0.02 * n(ks[18], (DEPTH, HEAD_DIM), f32),
        "k_norm": 1.0 + 0.02 * n(ks[19], (DEPTH, HEAD_DIM), f32),
        "w_out": n(ks[20], (DEPTH, D, D), f32) * (D ** -0.5 * DEEPNORM_BETA),
        "ln_g": 1.0 + 0.02 * n(ks[21], (DEPTH, D), f32),
        "ln_b": n(ks[22], (DEPTH, D), f32) * 0.01,
    }


def reference(x, c, ctx, c_ctx, w_ada, b_ada, w_in, pool_w, pool_scale, hy_conv_w, hy_conv_b,
              hy_w1, hy_b1, hy_freq, hy_w2, hy_b2, hy_w3, hy_bias, q_norm, k_norm, w_out, ln_g, ln_b):
    B, L, _ = x.shape
    Lc = ctx.shape[1]
    cos, sin = _axial_rope(L)
    for i in range(DEPTH):
        last = i == DEPTH - 1
        mx = jax.nn.silu(c) @ w_ada[i] + b_ada[i]
        shift_x, scale_x, gate_x = jnp.split(mx[:, None, :], 3, axis=-1)
        mc = jax.nn.silu(c_ctx) @ w_ada[i] + b_ada[i]
        shift_c, scale_c, gate_c = jnp.split(mc, 3, axis=-1)
        hx = _layernorm(x) * (1.0 + scale_x) + shift_x
        hc = _layernorm(ctx) * (1.0 + scale_c) + shift_c
        hy_args = (hy_conv_w[i], hy_conv_b[i], hy_w1[i], hy_b1[i], hy_freq[i], hy_w2[i], hy_b2[i], hy_w3[i], hy_bias[i])

        if last:
            kc_raw, vc_raw = jnp.split(hc @ w_in[i][:, K_OFF:KV_END], [KV_WIDTH], axis=-1)
            pc = None
        else:
            pc = jnp.split(hc @ w_in[i], SPLIT_POINTS, axis=-1)
            kc_raw, vc_raw = pc[5], pc[6]
        kc = _rms_head(_heads_kv(kc_raw, B, Lc), k_norm[i])
        vc = _heads_kv(vc_raw, B, Lc)

        px = jnp.split(hx @ w_in[i], SPLIT_POINTS, axis=-1)
        qx = _apply_rope(_heads_q(px[4], q_norm[i], B, L), cos, sin).reshape(B, L, ATTN_KV_HEADS, ATTN_GROUP, HEAD_DIM)
        kx = _apply_rope(_rms_head(_heads_kv(px[5], B, L), k_norm[i]), cos, sin)
        vx = _heads_kv(px[6], B, L)
        k_all = jnp.concatenate([kx, kc], axis=1)
        v_all = jnp.concatenate([vx, vc], axis=1)
        ox = _blocked_attention(qx, k_all, v_all).reshape(B, L, ATTN_WIDTH)
        yx = _merge(px, ox, pool_w[i], pool_scale[i], hy_args, w_out[i])
        x_new = _layernorm(DEEPNORM_ALPHA * x + gate_x * yx) * ln_g[i] + ln_b[i]

        if not last:
            qc = _heads_q(pc[4], q_norm[i], B, Lc).reshape(B, Lc, ATTN_KV_HEADS, ATTN_GROUP, HEAD_DIM)
            oc = _sdpa(qc, kc, vc).reshape(B, Lc, ATTN_WIDTH)
            yc = _merge(pc, oc, pool_w[i], pool_scale[i], hy_args, w_out[i])
            ctx = _layernorm(DEEPNORM_ALPHA * ctx + gate_c * yc) * ln_g[i] + ln_b[i]
        x = x_new
    return x
```

```cpp
#include <hip/hip_runtime.h>
#include <hip/hip_cooperative_groups.h>
#include <hip/hip_bf16.h>
#include <cstdio>
#include <cstdint>
#include <cmath>
namespace cg = cooperative_groups;
__device__ __forceinline__ int fresh_lane() { int l; asm volatile("v_mbcnt_lo_u32_b32 %0, -1, 0\n\tv_mbcnt_hi_u32_b32 %0, -1, %0" : "=v"(l)); return l; }
namespace pg8 {
#define PG8_LAS __attribute__((address_space(3)))
typedef unsigned short bf16_t;
typedef short bf16x8 __attribute__((ext_vector_type(8)));
typedef float f32x4 __attribute__((ext_vector_type(4)));
typedef unsigned u32x4 __attribute__((ext_vector_type(4)));
constexpr int BM = 256, BK = 64, HALF = 128, HTB = HALF * BK * 2  , STAGE_BYTES = 8 * HTB, NXCD = 8, WGM = 8;

__host__ __device__ __forceinline__ int lds_byte(int r, int c) { const int st = (r >> 4) * 2 + (c >> 5), rr = r & 15, cc = c & 31, ob = rr * 64 + cc * 2; return st * 1024 + (ob ^ (((ob >> 9) & 1) << 5)); }
__host__ __device__ __forceinline__ void stage_rc(int b, int& R, int& C) { const int st = b / 1024, sb = b % 1024, swz = sb ^ (((sb >> 9) & 1) << 5); R = (st >> 1) * 16 + swz / 64; C = (st & 1) * 32 + (swz % 64) / 2; }
__host__ __device__ __forceinline__ int perm32(int rho) { const int n = rho >> 4, i = rho & 15; return 8 * (i >> 2) + 4 * n + (i & 3); }

struct Unit { int pm, pn; };
struct Gemm { const bf16_t* A; const bf16_t* Bt; int M, N, K; };

__device__ __forceinline__ void map_linear(int wgid, int nM, int nN, Unit& u) {
    const int nwg = nM * nN;
    { const int q = nwg / NXCD, r = nwg % NXCD, xcd = wgid % NXCD, off = wgid / NXCD; wgid = (xcd < r ? xcd * (q + 1) : r * (q + 1) + (xcd - r) * q) + off; }
    const int nig = WGM * nN, gid = wgid / nig, fm = gid * WGM, gsz = (nM - fm) < WGM ? (nM - fm) : WGM;
    u.pm = fm + ((wgid % nig) % gsz); u.pn = (wgid % nig) / gsz;
}
struct GridOrder {
    int nM, nN, extra, extra_pm0, extra_pn, G, c;
    __device__ __forceinline__ bool next(int i, Unit& u) const {
        const long L = (long)i * G + c; const int nwg = nM * nN;
        if (L < nwg) { map_linear((int)L, nM, nN, u); return true; }
        if (L < nwg + extra) { u.pm = extra_pm0 + (int)(L - nwg); u.pn = extra_pn; return true; }
        return false;
    }
    __device__ __forceinline__ void a_ready(const Unit&) const {}
    __device__ __forceinline__ void done(const Unit&) const {}
};

__device__ __forceinline__ unsigned cvt_pk_bf16(float lo, float hi) { unsigned r; asm volatile("v_cvt_pk_bf16_f32 %0, %1, %2" : "=v"(r) : "v"(lo), "v"(hi)); return r; }
__device__ __forceinline__ float silu_f(float x) { return x * __builtin_amdgcn_rcpf(1.0f + __expf(-x)); }
typedef unsigned u32x2 __attribute__((ext_vector_type(2)));
constexpr int NINW = 2816, KVP = 128, KVROWS = 2304;
constexpr float QSCALE = 0.125f * 1.4426950408889634f;

struct EpiIn {
    static constexpr bool PERM = false, AFTER_DRAIN = false;
    bf16_t* PX; bf16_t* KALL; bf16_t* VALL; bf16_t* HYT; bf16_t* HYTC; const float* qn; const float* kn; const float* rope; PG8_LAS unsigned char* stg0;
    __device__ __forceinline__ void operator()(const f32x4 (&acc)[2][2][4][2], const Unit& u, int wr, int wc, int fr, int fq) const {
        asm volatile("" : "+v"(fr), "+v"(fq));
        const int pn = u.pn; const bool isctx = u.pm >= 256;
        const int rowt = u.pm * 256 + wr * 64 + fr;
        if (pn >= 6 && pn <= 8) {
            const bool isv = (pn == 8) && (wc >= 2); const bool isq = pn != 8;
            const float* gw = isq ? qn : kn;
            f32x4 g[2][2];
#pragma unroll
            for (int bj = 0; bj < 2; ++bj)
#pragma unroll
                for (int n = 0; n < 2; ++n) g[bj][n] = *(const f32x4*)(gw + 32 * bj + 16 * n + 4 * fq);
            const int bb = isctx ? (u.pm - 256) : (u.pm >> 3);
#pragma unroll
            for (int ai = 0; ai < 2; ++ai)
#pragma unroll
                for (int m = 0; m < 4; ++m) {
                    const int row = rowt + 128 * ai + 16 * m;
                    const int t = isctx ? (row & 255) : (row & 2047);
                    f32x4 x[2][2];
#pragma unroll
                    for (int bj = 0; bj < 2; ++bj)
#pragma unroll
                        for (int n = 0; n < 2; ++n) x[bj][n] = acc[ai][bj][m][n];
                    if (!isv) {
                        float ss = 0.f;
#pragma unroll
                        for (int bj = 0; bj < 2; ++bj)
#pragma unroll
                            for (int n = 0; n < 2; ++n) ss += (x[bj][n][0] * x[bj][n][0] + x[bj][n][1] * x[bj][n][1]) + (x[bj][n][2] * x[bj][n][2] + x[bj][n][3] * x[bj][n][3]);
                        ss += __shfl_xor(ss, 16); ss += __shfl_xor(ss, 32);
                        const float rs = 1.0f / sqrtf(ss * (1.0f / 64.0f) + 1e-6f);
#pragma unroll
                        for (int bj = 0; bj < 2; ++bj)
#pragma unroll
                            for (int n = 0; n < 2; ++n) x[bj][n] = x[bj][n] * rs * g[bj][n];
                        if (!isctx) {
#pragma unroll
                            for (int bj = 0; bj < 2; ++bj) {
                                const int pos = bj == 0 ? (t >> 6) : (t & 63);
                                const f32x4 cs0 = *(const f32x4*)(rope + (pos * 16 + 4 * fq) * 2), cs1 = *(const f32x4*)(rope + (pos * 16 + 4 * fq) * 2 + 4);
                                const float cc[4] = {cs0[0], cs0[2], cs1[0], cs1[2]}, sn[4] = {cs0[1], cs0[3], cs1[1], cs1[3]};
#pragma unroll
                                for (int e = 0; e < 4; ++e) { const float a = x[bj][0][e], b = x[bj][1][e]; x[bj][0][e] = a * cc[e] - b * sn[e]; x[bj][1][e] = a * sn[e] + b * cc[e]; }
                            }
                        }
                        if (isq) {
#pragma unroll
                            for (int bj = 0; bj < 2; ++bj)
#pragma unroll
                                for (int n = 0; n < 2; ++n) x[bj][n] = x[bj][n] * QSCALE;
                        }
                    }
                    bf16_t* dst;
                    if (isq) dst = PX + (size_t)row * NINW + 1536 + 256 * (pn - 6) + 64 * wc + 4 * fq;
                    else { const int tk = isctx ? (2048 + t) : t; dst = (isv ? VALL : KALL) + ((size_t)bb * KVROWS + tk) * KVP + 64 * (wc & 1) + 4 * fq; }
#pragma unroll
                    for (int bj = 0; bj < 2; ++bj)
#pragma unroll
                        for (int n = 0; n < 2; ++n) { u32x2 w; w.x = cvt_pk_bf16(x[bj][n][0], x[bj][n][1]); w.y = cvt_pk_bf16(x[bj][n][2], x[bj][n][3]); *(u32x2*)(dst + 32 * bj + 16 * n) = w; }
                    asm volatile("" ::: "memory");
                }
        } else {
            const bool dosilu = (pn == 1) || (pn == 5) || (pn >= 9);
            const bool dotr = (pn == 3) || (pn == 4);
            const int wid = wr * 4 + wc;
            PG8_LAS unsigned char* stg = stg0 + wid * 2304;
            bf16_t* hyt; int Lq, s0, bb;
            if (isctx) { hyt = HYTC + (size_t)(pn - 3) * 256 * 32 * 256; Lq = 256; s0 = 0; bb = u.pm - 256; }
            else { hyt = HYT + (size_t)(pn - 3) * 256 * 32 * 2048; Lq = 2048; s0 = (u.pm & 7) * 256; bb = u.pm >> 3; }
#pragma unroll
            for (int ai = 0; ai < 2; ++ai)
#pragma unroll
                for (int bj = 0; bj < 2; ++bj) {
                    f32x4 v[4][2];
#pragma unroll
                    for (int m = 0; m < 4; ++m)
#pragma unroll
                        for (int n = 0; n < 2; ++n) { v[m][n] = acc[ai][bj][m][n];
                            if (dosilu) { v[m][n][0] = silu_f(v[m][n][0]); v[m][n][1] = silu_f(v[m][n][1]); v[m][n][2] = silu_f(v[m][n][2]); v[m][n][3] = silu_f(v[m][n][3]); } }
#pragma unroll
                    for (int m = 0; m < 4; ++m) { const int row = rowt + 128 * ai + 16 * m;
                        u32x4 w; w.x = cvt_pk_bf16(v[m][0][0], v[m][0][1]); w.y = cvt_pk_bf16(v[m][0][2], v[m][0][3]); w.z = cvt_pk_bf16(v[m][1][0], v[m][1][1]); w.w = cvt_pk_bf16(v[m][1][2], v[m][1][3]);
                        *(u32x4*)(PX + (size_t)row * NINW + 256 * pn + 128 * bj + 32 * wc + 8 * fq) = w; }
                    if (dotr) {
                        const int lane = fq * 16 + fr;
#pragma unroll
                        for (int n = 0; n < 2; ++n) {
#pragma unroll
                            for (int m = 0; m < 4; ++m)
#pragma unroll
                                for (int e = 0; e < 4; ++e) { const unsigned bits = cvt_pk_bf16(v[m][n][e], 0.f); *(PG8_LAS unsigned short*)(stg + (4 * fq + e) * 144 + (16 * m + fr) * 2) = (unsigned short)bits; }
#pragma unroll
                            for (int k = 0; k < 2; ++k) { const int piece = lane + 64 * k, cs = piece >> 3, chunk = piece & 7;
                                const u32x4 w = *(const PG8_LAS u32x4*)(stg + cs * 144 + chunk * 16);
                                const int ch = 128 * bj + 32 * wc + 8 * (cs >> 2) + 4 * n + (cs & 3);
                                *(u32x4*)(hyt + ((size_t)ch * 32 + bb) * Lq + s0 + 128 * ai + 64 * wr + 8 * chunk) = w; }
                        }
                    }
                    asm volatile("" ::: "memory");
                }
        }
    }
};

constexpr float DN_ALPHA = 1.4142135623730951f;
struct EpiOut {
    static constexpr bool PERM = false, AFTER_DRAIN = false;
    const float* xres_lat; const float* xres_ctx; float* out_lat; float* out_ctx; const float* gate;
    __device__ __forceinline__ void operator()(const f32x4 (&acc)[2][2][4][2], const Unit& u, int wr, int wc, int fr, int fq) const {
        asm volatile("" : "+v"(fr), "+v"(fq));
        const bool isctx = u.pm >= 256; const int bb = isctx ? 32 : (u.pm >> 3);
        const float* xr = isctx ? xres_ctx : xres_lat; float* op = isctx ? out_ctx : out_lat;
        const int rowt = (isctx ? (u.pm - 256) : u.pm) * 256 + wr * 64 + fr, col0 = u.pn * 256 + wc * 32 + 4 * fq;
        f32x4 gv[2][2];
#pragma unroll
        for (int bj = 0; bj < 2; ++bj)
#pragma unroll
            for (int n = 0; n < 2; ++n) gv[bj][n] = *(const f32x4*)(gate + (size_t)bb * 3072 + 2048 + col0 + 128 * bj + 16 * n);
#pragma unroll
        for (int ai = 0; ai < 2; ++ai)
#pragma unroll
            for (int m = 0; m < 4; ++m) { const size_t off = (size_t)(rowt + 128 * ai + 16 * m) * 1024 + col0;
#pragma unroll
                for (int bj = 0; bj < 2; ++bj)
#pragma unroll
                    for (int n = 0; n < 2; ++n) { const f32x4 xv = *(const f32x4*)(xr + off + 128 * bj + 16 * n);
                        *(f32x4*)(op + off + 128 * bj + 16 * n) = xv * DN_ALPHA + gv[bj][n] * acc[ai][bj][m][n]; }
                if (m & 1) asm volatile("" ::: "memory"); }
    }
};

template <class Epi, class Sched, bool ALIGN_EPI = false, bool SP2 = false>
__device__ __forceinline__ void gemm_phase(PG8_LAS unsigned char* lds, const Gemm g, const Sched& S, const Epi& E, int wave0) {
    const int lane = fresh_lane(), wid = wave0, tid = wid * 64 + lane, wr = wid >> 2, wc = wid & 3, fr = lane & 15, fq = lane >> 4;
    const int K = g.K, nt = K / BK;
    unsigned voffA[2], voffB[2];
#pragma unroll
    for (int i = 0; i < 2; ++i) { int R, C; stage_rc(tid * 16 + i * 8192, R, C); const int Rb = Epi::PERM ? ((R & ~31) + perm32(R & 31)) : R;
        voffA[i] = (unsigned)(R * K + C) * 2u; voffB[i] = (unsigned)(Rb * K + C) * 2u; }
    const size_t kstep = (size_t)(BK * 2);
    const size_t hstep = (size_t)HALF * K * 2;
    const size_t tstep = 2 * hstep;
    const unsigned ldsw = (unsigned)wid * 1024u;
    const int aoff = lds_byte(wr * 64 + fr, fq * 8), boff = lds_byte(wc * 32 + fr, fq * 8);
#define PG8_SA(b, h) (((b) * 2 + (h)) * HTB)
#define PG8_SB(b, h) ((4 + (b) * 2 + (h)) * HTB)
#define PG8_STAGE(bufoff, gbase, voff) do { _Pragma("unroll") for (int _i = 0; _i < 2; ++_i) \
        __builtin_amdgcn_global_load_lds((const unsigned*)((const char*)(gbase) + (voff)[_i]), (PG8_LAS unsigned*)(lds + (bufoff) + ldsw + _i * 8192), 16, 0, 0); } while (0)
#define PG8_LDA(dst, b, h) do { _Pragma("unroll") for (int m = 0; m < 4; ++m) _Pragma("unroll") for (int k = 0; k < 2; ++k) dst[m][k] = *(const PG8_LAS bf16x8*)(lds + PG8_SA(b, h) + aoff + m * 2048 + k * 1024); } while (0)
#define PG8_LDB(dst, b, h) do { _Pragma("unroll") for (int n = 0; n < 2; ++n) _Pragma("unroll") for (int k = 0; k < 2; ++k) dst[n][k] = *(const PG8_LAS bf16x8*)(lds + PG8_SB(b, h) + boff + n * 2048 + k * 1024); } while (0)
#define PG8_MMA(ai, bj, At, Bt) do { __builtin_amdgcn_s_setprio(1); _Pragma("unroll") for (int m = 0; m < 4; ++m) _Pragma("unroll") for (int n = 0; n < 2; ++n) _Pragma("unroll") for (int k = 0; k < 2; ++k) \
        acc[ai][bj][m][n] = __builtin_amdgcn_mfma_f32_16x16x32_bf16(Bt[n][k], At[m][k], acc[ai][bj][m][n], 0, 0, 0); __builtin_amdgcn_s_setprio(0); } while (0)
#define PG8_WAIT_V(n) asm volatile("s_waitcnt vmcnt(" #n ")" ::: "memory")
#define PG8_WAIT_L(n) asm volatile("s_waitcnt lgkmcnt(" #n ")" ::: "memory")
#define PG8_BAR __builtin_amdgcn_s_barrier()
#define PG8_SCHED __builtin_amdgcn_sched_barrier(0)
    Unit cur, nxt; int ui = 0;
    if (!S.next(0, cur)) return;
    f32x4 acc[2][2][4][2];
#pragma unroll
    for (int a = 0; a < 2; ++a)
#pragma unroll
        for (int b = 0; b < 2; ++b)
#pragma unroll
            for (int m = 0; m < 4; ++m)
#pragma unroll
                for (int n = 0; n < 2; ++n) acc[a][b][m][n] = (f32x4){0.f, 0.f, 0.f, 0.f};
    bf16x8 At[4][2], B0[2][2], B1[2][2];
    const char* cA = (const char*)g.A + (size_t)cur.pm * tstep; const char* cB = (const char*)g.Bt + (size_t)cur.pn * tstep;
    S.a_ready(cur);
    if constexpr (SP2) {
        PG8_STAGE(PG8_SB(0, 0), cB, voffB); PG8_STAGE(PG8_SB(0, 1), cB + hstep, voffB); PG8_STAGE(PG8_SA(0, 0), cA, voffA); PG8_STAGE(PG8_SA(0, 1), cA + hstep, voffA);
        if (wr == 1) PG8_BAR;
        PG8_WAIT_V(2); PG8_BAR;
        PG8_STAGE(PG8_SB(1, 0), cB + kstep, voffB); PG8_STAGE(PG8_SA(1, 0), cA + kstep, voffA); PG8_STAGE(PG8_SB(1, 1), cB + hstep + kstep, voffB);
        PG8_WAIT_V(6); PG8_BAR;
    } else {
        PG8_STAGE(PG8_SB(0, 0), cB, voffB); PG8_STAGE(PG8_SA(0, 0), cA, voffA); PG8_STAGE(PG8_SB(0, 1), cB + hstep, voffB); PG8_STAGE(PG8_SA(0, 1), cA + hstep, voffA);
        if (wr == 1) PG8_BAR;
        PG8_WAIT_V(4); PG8_BAR;
        PG8_STAGE(PG8_SB(1, 0), cB + kstep, voffB); PG8_STAGE(PG8_SA(1, 0), cA + kstep, voffA); PG8_STAGE(PG8_SB(1, 1), cB + hstep + kstep, voffB);
        PG8_WAIT_V(6); PG8_BAR;
    }
    for (;;) {
        const bool has_next = S.next(ui + 1, nxt);
        const char* nA = has_next ? (const char*)g.A + (size_t)nxt.pm * tstep : cA; const char* nB = has_next ? (const char*)g.Bt + (size_t)nxt.pn * tstep : cB;
        for (int t = 0; t < nt; t += 2) {
            const bool last = (t == nt - 2);
            const char* a1 = cA + (size_t)(t + 1) * kstep;
            const char* a2 = last ? nA : cA + (size_t)(t + 2) * kstep; const char* b2 = last ? nB : cB + (size_t)(t + 2) * kstep;
            const char* a3 = a2 + kstep; const char* b3 = b2 + kstep;
            if (last && has_next) S.a_ready(nxt);
            if constexpr (SP2) {
            PG8_LDB(B0, 0, 0); PG8_LDB(B1, 0, 1); PG8_SCHED; PG8_LDA(At, 0, 0); PG8_STAGE(PG8_SA(1, 1), a1 + hstep, voffA);
            PG8_WAIT_V(8); PG8_WAIT_L(0); PG8_BAR; PG8_MMA(0, 0, At, B0); PG8_MMA(0, 1, At, B1); PG8_BAR; PG8_SCHED;
            PG8_LDA(At, 0, 1); PG8_STAGE(PG8_SB(0, 0), b2, voffB); PG8_STAGE(PG8_SB(0, 1), b2 + hstep, voffB); PG8_STAGE(PG8_SA(0, 0), a2, voffA);
            PG8_WAIT_V(8); PG8_WAIT_L(0); PG8_BAR; PG8_MMA(1, 0, At, B0); PG8_MMA(1, 1, At, B1); PG8_BAR; PG8_SCHED;
            PG8_LDB(B0, 1, 0); PG8_LDB(B1, 1, 1); PG8_SCHED; PG8_LDA(At, 1, 0); PG8_STAGE(PG8_SA(0, 1), a2 + hstep, voffA);
            PG8_WAIT_V(8); PG8_WAIT_L(0); PG8_BAR; PG8_MMA(0, 0, At, B0); PG8_MMA(0, 1, At, B1); PG8_BAR; PG8_SCHED;
            PG8_LDA(At, 1, 1); PG8_STAGE(PG8_SB(1, 0), b3, voffB); PG8_STAGE(PG8_SB(1, 1), b3 + hstep, voffB); PG8_STAGE(PG8_SA(1, 0), a3, voffA);
            PG8_WAIT_V(8); PG8_WAIT_L(0); PG8_BAR; PG8_MMA(1, 0, At, B0); PG8_MMA(1, 1, At, B1); PG8_BAR; PG8_SCHED;
            } else {
            PG8_LDB(B0, 0, 0); PG8_SCHED; PG8_LDA(At, 0, 0); PG8_STAGE(PG8_SA(1, 1), a1 + hstep, voffA);
            PG8_WAIT_L(8); PG8_BAR; PG8_WAIT_L(0); PG8_MMA(0, 0, At, B0); PG8_BAR; PG8_SCHED;
            PG8_LDB(B1, 0, 1); PG8_STAGE(PG8_SB(0, 0), b2, voffB);
            PG8_BAR; PG8_WAIT_L(0); PG8_MMA(0, 1, At, B1); PG8_BAR;
            PG8_LDA(At, 0, 1); PG8_STAGE(PG8_SA(0, 0), a2, voffA);
            PG8_BAR; PG8_WAIT_L(0); PG8_MMA(1, 0, At, B0); PG8_BAR; PG8_SCHED;
            PG8_STAGE(PG8_SB(0, 1), b2 + hstep, voffB);
            PG8_WAIT_V(6); PG8_BAR; PG8_MMA(1, 1, At, B1); PG8_BAR;
            PG8_LDB(B0, 1, 0); PG8_SCHED; PG8_LDA(At, 1, 0); PG8_STAGE(PG8_SA(0, 1), a2 + hstep, voffA);
            PG8_WAIT_L(8); PG8_BAR; PG8_WAIT_L(0); PG8_MMA(0, 0, At, B0); PG8_BAR; PG8_SCHED;
            PG8_LDB(B1, 1, 1); PG8_STAGE(PG8_SB(1, 0), b3, voffB);
            PG8_BAR; PG8_WAIT_L(0); PG8_MMA(0, 1, At, B1); PG8_BAR;
            PG8_LDA(At, 1, 1); PG8_STAGE(PG8_SA(1, 0), a3, voffA);
            PG8_BAR; PG8_WAIT_L(0); PG8_MMA(1, 0, At, B0); PG8_BAR; PG8_SCHED;
            PG8_STAGE(PG8_SB(1, 1), b3 + hstep, voffB);
            PG8_WAIT_V(6); PG8_BAR; PG8_MMA(1, 1, At, B1); PG8_BAR;
            }
        }
        if constexpr (ALIGN_EPI) { if (wr == 0) PG8_BAR; }
        if constexpr (!Epi::AFTER_DRAIN) { E(acc, cur, wr, wc, fr, fq); S.done(cur); }
        if (!has_next) break;
#pragma unroll
        for (int a = 0; a < 2; ++a)
#pragma unroll
            for (int b = 0; b < 2; ++b)
#pragma unroll
                for (int m = 0; m < 4; ++m)
#pragma unroll
                    for (int n = 0; n < 2; ++n) acc[a][b][m][n] = (f32x4){0.f, 0.f, 0.f, 0.f};
        cur = nxt; cA = nA; cB = nB; ++ui;
        if constexpr (ALIGN_EPI) { if (wr == 1) PG8_BAR; }
    }
    PG8_WAIT_V(0);
    if constexpr (!ALIGN_EPI) { if (wr == 0) PG8_BAR; }
    PG8_BAR;
    if constexpr (Epi::AFTER_DRAIN) { E.fused(acc, cur, wr, wc, fr, fq, lds, wid, lane); S.done(cur); }
#undef PG8_SA
#undef PG8_SB
#undef PG8_STAGE
#undef PG8_LDA
#undef PG8_LDB
#undef PG8_MMA
#undef PG8_WAIT_V
#undef PG8_WAIT_L
#undef PG8_BAR
#undef PG8_SCHED
}
}
#define ATTN_STORE16(p,v) (*(u32x4*)(p)=(v))
namespace attn_body {
using bf16=__hip_bfloat16;
using bf16x8=__attribute__((ext_vector_type(8)))short;
using s16x4=__attribute__((ext_vector_type(4)))short;
using f32x16=__attribute__((ext_vector_type(16)))float;
using u32x4=__attribute__((ext_vector_type(4)))unsigned;
constexpr int D=64;
constexpr int NW=8,QBLK=32,QB=QBLK*NW,KVBLK=64;
__device__ __forceinline__ int crow(int r,int hi){return (r&3)+8*(r>>2)+4*hi;}
#define SBAR() __builtin_amdgcn_sched_barrier(0)

constexpr int NSLOT=3, SLOTB=8192;
constexpr int LDS_K=0, LDS_V=NSLOT*SLOTB, LDS_WS=2*NSLOT*SLOTB, LDS_OST=LDS_WS+NW*64*4, LDS_BYTES=LDS_OST+NW*4096;
constexpr float C2=0.125f*1.4426950408889634f;
__device__ __forceinline__ void glds16(const void*gsrc,unsigned lds_dst){unsigned keep;
  asm volatile("s_mov_b32 %0, m0\n\ts_mov_b32 m0, %2\n\ts_nop 0\n\tglobal_load_lds_dwordx4 %1, off\n\ts_mov_b32 m0, %0":"=&s"(keep):"v"(gsrc),"s"(lds_dst):"memory");}
__device__ __forceinline__ float max3f(float a,float b,float c){float r;asm("v_max3_f32 %0, %1, %2, %3":"=v"(r):"v"(a),"v"(b),"v"(c));return r;}
__device__ __forceinline__ float max2f(float a,float b){float r;asm("v_max_f32_e32 %0, %1, %2":"=v"(r):"v"(a),"v"(b));return r;}
__device__ __forceinline__ float fadd_s(float a,float b){float r;asm("v_add_f32_e32 %0, %1, %2":"=v"(r):"v"(a),"v"(b));return r;}
__device__ __forceinline__ float fsub_s(float a,float b){float r;asm("v_sub_f32_e32 %0, %1, %2":"=v"(r):"v"(a),"v"(b));return r;}
typedef float f32x2_t __attribute__((ext_vector_type(2))); typedef __bf16 bf16x2_t __attribute__((ext_vector_type(2)));
__device__ __forceinline__ unsigned cvtpk_s(float lo,float hi){f32x2_t v={lo,hi};bf16x2_t b=__builtin_convertvector(v,bf16x2_t);return __builtin_bit_cast(unsigned,b);}
#define WAIT_BAR(N) asm volatile("s_waitcnt vmcnt(" #N ") lgkmcnt(0)\n\ts_barrier":::"memory")

__device__ __forceinline__ void qkt(f32x16&p0,f32x16&p1,const char*Kslot,const bf16x8*qr,const f32x16&negm,int r32,int hi){
  const char*kb=Kslot+hi*1024+r32*16;
  #pragma unroll
  for(int d0=0;d0<4;++d0){
    const bf16x8 b0=*reinterpret_cast<const bf16x8*>(kb+d0*2048);
    const bf16x8 b1=*reinterpret_cast<const bf16x8*>(kb+d0*2048+512);
    if(d0==0){p0=__builtin_amdgcn_mfma_f32_32x32x16_bf16(b0,qr[0],negm,0,0,0);p1=__builtin_amdgcn_mfma_f32_32x32x16_bf16(b1,qr[0],negm,0,0,0);}
    else{p0=__builtin_amdgcn_mfma_f32_32x32x16_bf16(b0,qr[d0],p0,0,0,0);p1=__builtin_amdgcn_mfma_f32_32x32x16_bf16(b1,qr[d0],p1,0,0,0);}}
}
typedef __attribute__((address_space(3))) const char* lds_cptr;
typedef short v4i16_t __attribute__((ext_vector_type(4)));
__device__ __forceinline__ void kload8(bf16x8*kf,lds_cptr kp){
  kf[0]=*(const __attribute__((address_space(3))) bf16x8*)(kp);      kf[1]=*(const __attribute__((address_space(3))) bf16x8*)(kp+512);
  kf[2]=*(const __attribute__((address_space(3))) bf16x8*)(kp+2048); kf[3]=*(const __attribute__((address_space(3))) bf16x8*)(kp+2560);
  kf[4]=*(const __attribute__((address_space(3))) bf16x8*)(kp+4096); kf[5]=*(const __attribute__((address_space(3))) bf16x8*)(kp+4608);
  kf[6]=*(const __attribute__((address_space(3))) bf16x8*)(kp+6144); kf[7]=*(const __attribute__((address_space(3))) bf16x8*)(kp+6656);
}
__device__ __forceinline__ void kload2(bf16x8*kf,lds_cptr kp,int j){ kf[2*j]=*(const __attribute__((address_space(3))) bf16x8*)(kp+j*2048); kf[2*j+1]=*(const __attribute__((address_space(3))) bf16x8*)(kp+j*2048+512); }
__device__ __forceinline__ s16x4 vtr(lds_cptr p){ return __builtin_bit_cast(s16x4,__builtin_amdgcn_ds_read_tr16_b64_v4i16((__attribute__((address_space(3))) v4i16_t*)p)); }
__device__ __forceinline__ float rowmax(const f32x16&p0,const f32x16&p1){
  float a=max3f(p0[0],p0[1],p1[0]),b=max3f(p0[2],p0[3],p1[1]);a=max3f(a,p1[2],p1[3]);
  #pragma unroll
  for(int r=4;r<16;r+=4){a=max3f(a,p0[r],p0[r+1]);b=max3f(b,p0[r+2],p0[r+3]);a=max3f(a,p1[r],p1[r+1]);b=max3f(b,p1[r+2],p1[r+3]);}
  const float m=max2f(a,b);
  auto rr=__builtin_amdgcn_permlane32_swap(__float_as_uint(m),__float_as_uint(m),false,false);
  return max2f(__uint_as_float(rr[0]),__uint_as_float(rr[1]));
}
__device__ __forceinline__ void pv(f32x16*o,int vb,bf16x8 pa0,bf16x8 pa1,bf16x8 pa2,bf16x8 pa3){
  #pragma unroll
  for(int d0=0;d0<2;++d0){s16x4 lo[4],hi[4];
    #pragma unroll
    for(int ks=0;ks<4;++ks){
      asm volatile("ds_read_b64_tr_b16 %0,%1 offset:%c2":"=&v"(lo[ks]):"v"(vb),"i"(d0*4096+ks*1024):"memory");
      asm volatile("ds_read_b64_tr_b16 %0,%1 offset:%c2":"=&v"(hi[ks]):"v"(vb),"i"(d0*4096+ks*1024+512):"memory");}
    asm volatile("s_waitcnt lgkmcnt(0)":::"memory");SBAR();
    #define PK(k) (bf16x8){lo[k][0],lo[k][1],lo[k][2],lo[k][3],hi[k][0],hi[k][1],hi[k][2],hi[k][3]}
    o[d0]=__builtin_amdgcn_mfma_f32_32x32x16_bf16(pa0,PK(0),o[d0],0,0,0);
    o[d0]=__builtin_amdgcn_mfma_f32_32x32x16_bf16(pa1,PK(1),o[d0],0,0,0);
    o[d0]=__builtin_amdgcn_mfma_f32_32x32x16_bf16(pa2,PK(2),o[d0],0,0,0);
    o[d0]=__builtin_amdgcn_mfma_f32_32x32x16_bf16(pa3,PK(3),o[d0],0,0,0);
    #undef PK
  }
}


template<int THRL> __device__ __forceinline__ void attn_unit(const bf16*Qw0,int qpitch,const bf16*__restrict__ Kh,const bf16*__restrict__ Vh,int kvpitch,int NT,bf16*Ow0,int opitch,const bf16*Gw0,int gpitch,char*shm,int wave0){
  const int lane=fresh_lane(),r32=lane&31,hi=lane>>5,wid=wave0,tid=wid*64+lane;
  const bf16*Qw=Qw0+(long)(wid*QBLK)*qpitch;
  const unsigned lds0=(unsigned)(uintptr_t)shm;
  float*wsf=(float*)(shm+LDS_WS)+wid*64;
  const bf16*ksrc=Kh+(long)lane*kvpitch+wid*8;
  const bf16*vsrc=Vh+(long)(16*(wid&3)+(lane>>2))*kvpitch+(wid>>2)*32+(lane&3)*8;
  const unsigned kdst=lds0+LDS_K+wid*1024, vdst=lds0+LDS_V+wid*1024;
  #define DMA_K(t,slot) glds16(ksrc+(long)(t)*KVBLK*kvpitch,(unsigned)__builtin_amdgcn_readfirstlane(kdst+(slot)))
  #define DMA_V(t,slot) glds16(vsrc+(long)(t)*KVBLK*kvpitch,(unsigned)__builtin_amdgcn_readfirstlane(vdst+(slot)))
  const int vb0=(int)(lds0+LDS_V)+((lane>>4)&1)*32+(lane&3)*8+(4*hi+((lane&15)>>2))*64;
  const char*Kbase=shm+LDS_K; bf16x8 kf[8];
  const lds_cptr shm3=(lds_cptr)shm; const lds_cptr kp0=shm3+LDS_K+hi*1024+r32*16; const lds_cptr vp0=shm3+LDS_V+((lane>>4)&1)*32+(lane&3)*8+(4*hi+((lane&15)>>2))*64;
  DMA_K(0,0);DMA_V(0,0);DMA_K(1,SLOTB);
  bf16x8 qr[4];
  #pragma unroll
  for(int d0=0;d0<4;++d0)qr[d0]=*reinterpret_cast<const bf16x8*>(&Qw[(long)r32*qpitch+d0*16+hi*8]);
  float mhat=0.f,l_reg=0.f;f32x16 o[2];o[0]=f32x16{};o[1]=f32x16{};f32x16 negm=f32x16{};asm volatile("":"+v"(negm));
  #define CMASK(P0,P1,t) do{}while(0)
  bool resc=false;
  #define START(P0,P1) do{ const float rm=rowmax(P0,P1); resc=false; \
    { const float dl=rm; mhat=fadd_s(mhat,dl); \
      _Pragma("unroll") for(int r=0;r<16;++r){P0[r]=fsub_s(P0[r],dl);P1[r]=fsub_s(P1[r],dl);} \
      _Pragma("unroll") for(int r=0;r<16;++r)negm[r]=-mhat; asm volatile("":"+v"(negm)); } \
    _Pragma("unroll") for(int r=0;r<16;++r)P0[r]=__builtin_amdgcn_exp2f(P0[r]); }while(0)
  #define RESC() do{ if(resc){ asm volatile("s_waitcnt lgkmcnt(0)":::"memory"); \
      _Pragma("unroll") for(int d_=0;d_<2;++d_) _Pragma("unroll") for(int r=0;r<16;++r)o[d_][r]*=wsf[crow(r,hi)]; } }while(0)
  f32x16 pA0,pA1,pB0,pB1;
  int sl_prev=0,sl_cur=0,sl_next=SLOTB;
  #define ROT() do{sl_prev=sl_cur;sl_cur=sl_next;sl_next=(sl_next==(NSLOT-1)*SLOTB)?0:sl_next+SLOTB;}while(0)
  DMA_K(2,2*SLOTB);
  WAIT_BAR(3);
  qkt(pA0,pA1,Kbase,qr,negm,r32,hi);asm volatile("s_nop 15\n\ts_nop 7":"+v"(pA0),"+v"(pA1));CMASK(pA0,pA1,0);
  START(pA0,pA1);
  _Pragma("unroll") for(int r=0;r<16;++r)pA1[r]=__builtin_amdgcn_exp2f(pA1[r]);
  WAIT_BAR(0);
  DMA_K(3,0);DMA_V(1,SLOTB);
  ROT();
  kload8(kf,kp0+sl_cur);
  WAIT_BAR(2);
  s16x4 vlo[8],vhi[8]; u32x4 pw0,pw1,pw2,pw3;
  #define PKW(P,B) cvtpk_s(P[B],P[B+1])
  #define PAF(k) __builtin_bit_cast(bf16x8,pw##k)
  #define VFR(i) (bf16x8){vlo[i][0],vlo[i][1],vlo[i][2],vlo[i][3],vhi[i][0],vhi[i][1],vhi[i][2],vhi[i][3]}
  #define PIN(x) asm volatile("":"+v"(x))
  #define MX3(a,b,c) __builtin_fmaxf(__builtin_fmaxf((a),(b)),(c))
  #define GAPA(MF,A0,A1,A2,A3,W0,W1,PW) do{ MF; sacc+=A0; sacc+=A1; sacc+=A2; sacc+=A3; PIN(sacc); W0; W1; PIN(PW); SBAR(); }while(0)
  #define EX(v) __builtin_amdgcn_exp2f(v)
  #define GAPB(MF,X,B) do{ MF; X[B]=EX(X[B]); X[B+1]=EX(X[B+1]); X[B+2]=EX(X[B+2]); X[B+3]=EX(X[B+3]); PIN(X); SBAR(); }while(0)
  #define VRD(i) do{ vlo[i]=vtr(vp_+(((i)>>2)*4096+((i)&3)*1024)); vhi[i]=vtr(vp_+(((i)>>2)*4096+((i)&3)*1024+512)); }while(0)
  #define KRD(G,j) do{ if(G){ kload2(kf,kp0+sl_next,j); SBAR(); } }while(0)
  #define STEP(C0,C1,P0,P1,t,GK,GV,GL) do{ SBAR(); \
    const lds_cptr vp_=vp0+sl_prev; \
    VRD(0); SBAR(); float sacc=(P0[0]+P0[1]); \
    GAPA(C0=__builtin_amdgcn_mfma_f32_32x32x16_bf16(kf[0],qr[0],negm,0,0,0), P0[2],P0[3],P0[4],P0[5],     pw0[0]=PKW(P0,0), pw0[1]=PKW(P0,2), pw0); \
    VRD(4); SBAR(); GAPA(C1=__builtin_amdgcn_mfma_f32_32x32x16_bf16(kf[1],qr[0],negm,0,0,0), P0[6],P0[7],P0[8],P0[9],     pw0[2]=PKW(P0,4), pw0[3]=PKW(P0,6), pw0); \
    VRD(1); SBAR(); GAPA(C0=__builtin_amdgcn_mfma_f32_32x32x16_bf16(kf[2],qr[1],C0,0,0,0),   P0[10],P0[11],P0[12],P0[13], pw1[0]=PKW(P0,8), pw1[1]=PKW(P0,10), pw1); \
    VRD(5); SBAR(); GAPA(C1=__builtin_amdgcn_mfma_f32_32x32x16_bf16(kf[3],qr[1],C1,0,0,0),   P0[14],P0[15],P1[0],P1[1],   pw1[2]=PKW(P0,12),pw1[3]=PKW(P0,14), pw1); \
    VRD(2); SBAR(); GAPA(C0=__builtin_amdgcn_mfma_f32_32x32x16_bf16(kf[4],qr[2],C0,0,0,0),   P1[2],P1[3],P1[4],P1[5],     pw2[0]=PKW(P1,0), pw2[1]=PKW(P1,2), pw2); \
    VRD(6); SBAR(); GAPA(C1=__builtin_amdgcn_mfma_f32_32x32x16_bf16(kf[5],qr[2],C1,0,0,0),   P1[6],P1[7],P1[8],P1[9],     pw2[2]=PKW(P1,4), pw2[3]=PKW(P1,6), pw2); \
    VRD(3); SBAR(); GAPA(C0=__builtin_amdgcn_mfma_f32_32x32x16_bf16(kf[6],qr[3],C0,0,0,0),   P1[10],P1[11],P1[12],P1[13], pw3[0]=PKW(P1,8), pw3[1]=PKW(P1,10), pw3); \
    VRD(7); SBAR(); GAPA(C1=__builtin_amdgcn_mfma_f32_32x32x16_bf16(kf[7],qr[3],C1,0,0,0),   P1[14],P1[15],0.f,0.f,       pw3[2]=PKW(P1,12),pw3[3]=PKW(P1,14), pw3); \
    l_reg+=sacc; \
    if(GK){DMA_K((t)+3,sl_cur);} if(GV){DMA_V((t)+1,sl_next);} \
    CMASK(C0,C1,t); \
    { float a=MX3(C0[0],C0[1],C1[0]),b=MX3(C0[2],C0[3],C1[1]); a=MX3(a,C1[2],C1[3]); \
      _Pragma("unroll") for(int r=4;r<16;r+=4){a=MX3(a,C0[r],C0[r+1]);b=MX3(b,C0[r+2],C0[r+3]);a=MX3(a,C1[r],C1[r+1]);b=MX3(b,C1[r+2],C1[r+3]);} \
      float rm=__builtin_fmaxf(a,b); { auto rr=__builtin_amdgcn_permlane32_swap(__float_as_uint(rm),__float_as_uint(rm),false,false); rm=__builtin_fmaxf(__uint_as_float(rr[0]),__uint_as_float(rr[1])); } \
      resc=false; \
      if(__builtin_expect(__any(rm>(float)THRL),0)){ const float dl=__builtin_fmaxf(rm,0.f); mhat+=dl; \
        _Pragma("unroll") for(int r=0;r<16;++r){C0[r]-=dl;C1[r]-=dl;} \
        _Pragma("unroll") for(int r=0;r<16;++r)negm[r]=-mhat; asm volatile("":"+v"(negm)); \
        const float f=__builtin_amdgcn_exp2f(-dl); l_reg*=f; if(hi==0)wsf[r32]=f; resc=true; } } \
    SBAR(); \
    GAPB(o[0]=__builtin_amdgcn_mfma_f32_32x32x16_bf16(PAF(0),VFR(0),o[0],0,0,0), C0,0); \
    GAPB(o[1]=__builtin_amdgcn_mfma_f32_32x32x16_bf16(PAF(0),VFR(4),o[1],0,0,0), C0,4); \
    KRD(GL,0); GAPB(o[0]=__builtin_amdgcn_mfma_f32_32x32x16_bf16(PAF(1),VFR(1),o[0],0,0,0), C0,8); \
    KRD(GL,1); GAPB(o[1]=__builtin_amdgcn_mfma_f32_32x32x16_bf16(PAF(1),VFR(5),o[1],0,0,0), C0,12); \
    KRD(GL,2); GAPB(o[0]=__builtin_amdgcn_mfma_f32_32x32x16_bf16(PAF(2),VFR(2),o[0],0,0,0), C1,0); \
    KRD(GL,3); GAPB(o[1]=__builtin_amdgcn_mfma_f32_32x32x16_bf16(PAF(2),VFR(6),o[1],0,0,0), C1,4); \
    GAPB(o[0]=__builtin_amdgcn_mfma_f32_32x32x16_bf16(PAF(3),VFR(3),o[0],0,0,0), C1,8); \
    GAPB(o[1]=__builtin_amdgcn_mfma_f32_32x32x16_bf16(PAF(3),VFR(7),o[1],0,0,0), C1,12); \
    }while(0)
  int t=1;
  #undef CMASK
  #define CMASK(P0,P1,t) do{}while(0)
  for(;t+5<NT;t+=2){
    STEP(pB0,pB1,pA0,pA1,t,true,true,true);     WAIT_BAR(2); RESC(); ROT();
    STEP(pA0,pA1,pB0,pB1,t+1,true,true,true);   WAIT_BAR(2); RESC(); ROT();
  }
  #undef CMASK
  #define CMASK(P0,P1,t) do{}while(0)
  #define ENDW(tt) do{ if((tt)+3<NT){WAIT_BAR(2);} else if((tt)+2<NT){WAIT_BAR(1);} else {WAIT_BAR(0);} }while(0)
  for(;t+1<NT;t+=2){
    STEP(pB0,pB1,pA0,pA1,t,(t+3<NT),(t+1<NT),(t+1<NT));       ENDW(t);   RESC(); ROT();
    STEP(pA0,pA1,pB0,pB1,t+1,(t+4<NT),(t+2<NT),(t+2<NT));     ENDW(t+1); RESC(); ROT();
  }
  STEP(pB0,pB1,pA0,pA1,NT-1,false,false,false); RESC();
  { float sacc=pB0[0]+pB0[1]; _Pragma("unroll") for(int r=2;r<16;++r)sacc+=pB0[r]; _Pragma("unroll") for(int r=0;r<16;++r)sacc+=pB1[r]; l_reg+=sacc;
    pw0=(u32x4){PKW(pB0,0),PKW(pB0,2),PKW(pB0,4),PKW(pB0,6)};pw1=(u32x4){PKW(pB0,8),PKW(pB0,10),PKW(pB0,12),PKW(pB0,14)};pw2=(u32x4){PKW(pB1,0),PKW(pB1,2),PKW(pB1,4),PKW(pB1,6)};pw3=(u32x4){PKW(pB1,8),PKW(pB1,10),PKW(pB1,12),PKW(pB1,14)};
    SBAR(); pv(o,vb0+sl_cur,PAF(0),PAF(1),PAF(2),PAF(3)); }
  #undef PKW
  #undef PAF
  #undef VFR
  #undef PIN
  #undef MX3
  #undef GAPA
  #undef GAPB
  #undef EX
  #undef VRD
  #undef KRD
  #undef STEP
  #undef ENDW
  {auto rr=__builtin_amdgcn_permlane32_swap(__float_as_uint(l_reg),__float_as_uint(l_reg),false,false);l_reg=__uint_as_float(rr[0])+__uint_as_float(rr[1]);}
  if(hi==0)wsf[32+r32]=l_reg;asm volatile("s_waitcnt lgkmcnt(0)":::"memory");
  float rli[16];
  #pragma unroll
  for(int r=0;r<16;++r)rli[r]=__builtin_amdgcn_rcpf(wsf[32+crow(r,hi)]);
  bf16*Ow=Ow0+(long)(wid*QBLK)*opitch; const bf16*Gw=Gw0+(long)(wid*QBLK)*gpitch;
  { bf16*stg=(bf16*)(shm+LDS_OST)+wid*2048;
    u32x4 gv[4];
    #pragma unroll
    for(int i=0;i<4;++i){const int row=i*8+(lane>>3),ch=lane&7; gv[i]=*(const u32x4*)(Gw+(long)row*gpitch+ch*8);}
    #pragma unroll
    for(int r=0;r<16;++r){const int orow=crow(r,hi);
      #pragma unroll
      for(int d0=0;d0<2;++d0)stg[orow*64+d0*32+r32]=__float2bfloat16(o[d0][r]*rli[r]);}
    asm volatile("s_waitcnt lgkmcnt(0)":::"memory");
    #pragma unroll
    for(int i=0;i<4;++i){const int row=i*8+(lane>>3),ch=lane&7; const u32x4 v=*(const u32x4*)(stg+row*64+ch*8); u32x4 w;
      #pragma unroll
      for(int q=0;q<4;++q){ const float a0=__uint_as_float(v[q]<<16),a1=__uint_as_float(v[q]&0xffff0000u),g0=__uint_as_float(gv[i][q]<<16),g1=__uint_as_float(gv[i][q]&0xffff0000u); w[q]=cvtpk_s(a0*g0,a1*g1); }
      ATTN_STORE16(Ow+(long)row*opitch+ch*8,w);} }
  asm volatile("s_waitcnt lgkmcnt(0)\n\ts_barrier":::"memory");
  #undef DMA_K
  #undef DMA_V
  #undef CMASK
  #undef START
  #undef RESC
  #undef ROT
}
constexpr int ATTN_LDS_BYTES=LDS_BYTES;
#undef SBAR
#undef WAIT_BAR
}
#define GAS __attribute__((address_space(1)))
#define LAS __attribute__((address_space(3)))
typedef unsigned short bf16;
typedef unsigned v4u __attribute__((ext_vector_type(4)));
typedef unsigned v2u __attribute__((ext_vector_type(2)));
typedef float f32x4 __attribute__((ext_vector_type(4)));
typedef float f32x16 __attribute__((ext_vector_type(16)));
typedef short bf16x8 __attribute__((ext_vector_type(8)));
constexpr int NWAVES = 8;
constexpr int NB = 32, LSEQ = 2048, LCTX = 256, DM = 1024, NIN = 2816;
constexpr int ROWS_X = NB * LSEQ, ROWS_C = NB * LCTX, MT = ROWS_X + ROWS_C;
constexpr float LN_EPS = 1e-6f;
constexpr size_t MiB = 1u << 20;
constexpr size_t WS_CTL = 0;
constexpr size_t WS_WIN = 1 * MiB;
constexpr size_t WS_WOUT = 12 * MiB;
constexpr size_t WS_PWT = 16 * MiB;
constexpr size_t WS_ROPE = WS_PWT + 65536;
constexpr size_t WS_MOD = WS_PWT + 131072;
constexpr size_t WS_MODP = 17 * MiB;
constexpr size_t WS_HF = 24 * MiB;
constexpr size_t WS_HX = 40 * MiB;
constexpr size_t WS_PX = 184 * MiB;
constexpr size_t WS_KALL = 580 * MiB;
constexpr size_t WS_VALL = 598 * MiB;
constexpr size_t WS_HYT = 616 * MiB;
constexpr size_t WS_HYTC = 680 * MiB;
constexpr size_t WS_YHT = 688 * MiB;
constexpr size_t WS_YHTC = 720 * MiB;
constexpr size_t WS_CTXR = 724 * MiB;
constexpr size_t WS_END = 756 * MiB;
constexpr int LDS_BYTES = 163840;
constexpr int STG_OFF = 131072;

__device__ __forceinline__ unsigned f2bf(float f) { unsigned u = __builtin_bit_cast(unsigned, f); return (u + 0x7fffu + ((u >> 16) & 1u)) >> 16; }
__device__ __forceinline__ unsigned pk2(float lo, float hi) { return f2bf(lo) | (f2bf(hi) << 16); }
__device__ __forceinline__ float bflo(unsigned w) { return __uint_as_float(w << 16); }
__device__ __forceinline__ float bfhi(unsigned w) { return __uint_as_float(w & 0xffff0000u); }
__device__ __forceinline__ float bf1(unsigned short h) { return __uint_as_float(((unsigned)h) << 16); }
__device__ __forceinline__ float wave_sum(float v) {
#pragma unroll
    for (int o = 1; o < 64; o <<= 1) v += __shfl_xor(v, o);
    return v;
}
__device__ __forceinline__ float rdlane(float v, int l) { return __int_as_float(__builtin_amdgcn_readlane(__float_as_int(v), l)); }
__device__ __forceinline__ float silu(float x) { return x / (1.0f + __expf(-x)); }

struct Frame {
    LAS unsigned char* lds;
    int tid, lane, wave, vcu, G;
    const float* const* in;
    float* out; unsigned char* ws;
};

__device__ __forceinline__ void p0_transpose_item(const float* W, int N, bf16* WT, bool permuted, LAS float* scr, int item, int lane) {
    const int nblk = N / 32, kb = item / nblk, nbp = item % nblk, k0 = 64 * kb, pb = 32 * nbp;
    int lb = pb; bool plainperm = false;
    if (permuted) { const int tile = pb >> 8, pc = pb & 255, bj = pc >> 7, wc = (pc >> 5) & 3;
        if (tile >= 6 && tile <= 8) lb = tile * 256 + 64 * wc + 32 * bj; else plainperm = true; }
#pragma unroll 8
    for (int i = 0; i < 32; ++i) { const int kk = 2 * i + (lane >> 5); scr[kk * 33 + (lane & 31)] = W[(size_t)(k0 + kk) * N + lb + (lane & 31)]; }
    asm volatile("s_waitcnt lgkmcnt(0)" ::: "memory");
    const int c = lane & 7;
#pragma unroll
    for (int j = 0; j < 4; ++j) { const int q = (lane >> 3) + 8 * j;
        const int lq = plainperm ? (8 * ((q >> 2) & 3) + 4 * (q >> 4) + (q & 3)) : q;
        const LAS float* s = scr + (8 * c) * 33 + lq;
        v4u o; o.x = pk2(s[0 * 33], s[1 * 33]); o.y = pk2(s[2 * 33], s[3 * 33]); o.z = pk2(s[4 * 33], s[5 * 33]); o.w = pk2(s[6 * 33], s[7 * 33]);
        *(v4u*)(WT + (size_t)(pb + q) * 1024 + k0 + 8 * c) = o; }
    asm volatile("s_waitcnt lgkmcnt(0)" ::: "memory");
}
__device__ __forceinline__ void p0_mod_task(const Frame& F, int task) {
    const int layer = task / 384, rem = task % 384, cgp = rem >> 3, kc = rem & 7, lane = F.lane;
    const float* W = F.in[4] + (size_t)layer * 1024 * 3072 + 64 * cgp + lane;
    const float* c = F.in[1]; const float* cc = F.in[3];
    float acc[33];
#pragma unroll
    for (int b = 0; b < 33; ++b) acc[b] = 0.f;
    for (int half = 0; half < 2; ++half) {
        const int k0 = 128 * kc + 64 * half;
        float sv[33];
#pragma unroll
        for (int b = 0; b < 32; ++b) sv[b] = silu(c[b * 1024 + k0 + lane]);
        sv[32] = silu(cc[k0 + lane]);
#pragma unroll 4
        for (int kk = 0; kk < 64; ++kk) { const float w = W[(size_t)(k0 + kk) * 3072];
#pragma unroll
            for (int b = 0; b < 33; ++b) acc[b] = fmaf(rdlane(sv[b], kk), w, acc[b]); }
    }
    float* P = (float*)(F.ws + WS_MODP) + ((size_t)(layer * 8 + kc) * 33) * 3072 + 64 * cgp + lane;
#pragma unroll
    for (int b = 0; b < 33; ++b) P[(size_t)b * 3072] = acc[b];
}
__device__ __forceinline__ void p0_filter_task(const Frame& F, int fidx, int t) {
    const int L = fidx == 2 ? 256 : 2048, layer = fidx == 1 ? 1 : 0, lane = F.lane;
    const float* w1 = F.in[11] + layer * 33 * 64; const float* b1 = F.in[12] + layer * 64; const float* fq = F.in[13] + layer * 128;
    const float* w2 = F.in[14] + layer * 64 * 64; const float* b2 = F.in[15] + layer * 64; const float* w3 = F.in[16] + layer * 64 * 512;
    const float tl = (float)t / (float)(L - 1);
    float z = 0.f;
    if (lane == 0) z = tl;
    else if (lane < 33) { const int j = (lane - 1) & 15; const double frj = 1e-4 + (double)j * ((15.0 - 1e-4) / 15.0);
        double ph = frj * (double)t / (double)L; ph -= floor(ph);
        const float a = (float)(2.0 * ph);
        z = lane < 17 ? cospif(a) : -sinpif(a); }
    float h1 = b1[lane];
    for (int j = 0; j < 33; ++j) h1 = fmaf(rdlane(z, j), w1[j * 64 + lane], h1);
    h1 = sinf(fq[lane] * h1);
    float h2 = b2[lane];
#pragma unroll 8
    for (int m = 0; m < 64; ++m) h2 = fmaf(rdlane(h1, m), w2[m * 64 + lane], h2);
    h2 = sinf(fq[64 + lane] * h2);
    float o[8];
#pragma unroll
    for (int q = 0; q < 8; ++q) o[q] = 0.f;
#pragma unroll 4
    for (int m = 0; m < 64; ++m) { const float hm = rdlane(h2, m);
#pragma unroll
        for (int q = 0; q < 8; ++q) o[q] = fmaf(hm, w3[m * 512 + 64 * q + lane], o[q]); }
    float* HF = (float*)(F.ws + WS_HF) + (fidx == 0 ? 0 : fidx == 1 ? (size_t)512 * 2048 : (size_t)2 * 512 * 2048);
    const float dmin = 3.0701134573253943f, dmax = 15.350567286626972f;
#pragma unroll
    for (int q = 0; q < 8; ++q) { const int cp = 64 * q + lane, ch = cp & 255; const float dl = dmin + (float)ch * ((dmax - dmin) / 255.0f);
        HF[(size_t)cp * L + t] = o[q] * __expf(-tl * dl); }
}
__device__ __forceinline__ void p0a_phase(const Frame& F) {
    LAS float* scr = (LAS float*)(F.lds + F.wave * 16384);
    const int gw = F.vcu * NWAVES + F.wave, NGW = F.G * NWAVES, lane = F.lane;
    constexpr int T_MOD = 768, T_FIL = 2 * 2048 + 256, T_WIN = 2 * 16 * 88, T_WOUT = 2 * 16 * 32, T_PW = 512, T_ROPE = 16;
    constexpr int NT = T_MOD + T_FIL + T_WIN + T_WOUT + T_PW + T_ROPE;
    for (int it = gw; it < NT; it += NGW) {
        int r = it;
        if (r < T_MOD) { p0_mod_task(F, r); continue; } r -= T_MOD;
        if (r < T_FIL) { if (r < 2048) p0_filter_task(F, 0, r); else if (r < 4096) p0_filter_task(F, 1, r - 2048); else p0_filter_task(F, 2, r - 4096); continue; } r -= T_FIL;
        if (r < T_WIN) { const int layer = r / (16 * 88); p0_transpose_item(F.in[6] + (size_t)layer * 1024 * NIN, NIN, (bf16*)(F.ws + WS_WIN) + (size_t)layer * NIN * 1024, true, scr, r % (16 * 88), lane); continue; } r -= T_WIN;
        if (r < T_WOUT) { const int layer = r / (16 * 32); p0_transpose_item(F.in[20] + (size_t)layer * 1024 * 1024, 1024, (bf16*)(F.ws + WS_WOUT) + (size_t)layer * 1024 * 1024, false, scr, r % (16 * 32), lane); continue; } r -= T_WOUT;
        if (r < T_PW) { const int lg = r >> 6, dout = r & 63;
            ((bf16*)(F.ws + WS_PWT))[(size_t)(lg * 64 + dout) * 64 + lane] = (bf16)f2bf(F.in[7][(size_t)(lg * 64 + lane) * 64 + dout]); continue; } r -= T_PW;
        { const int idx = r * 64 + lane, p = idx >> 4, i = idx & 15; const float inv = exp2f(-(float)i * (13.287712379549449f / 16.0f)); const float ang = (float)p * inv;
            float* R = (float*)(F.ws + WS_ROPE); R[2 * idx] = cosf(ang); R[2 * idx + 1] = sinf(ang); }
    }
}
__device__ __forceinline__ void ln_stats(const f32x4 (&v)[4], float& mean, float& rstd) {
    float s = 0.f;
#pragma unroll
    for (int j = 0; j < 4; ++j) s += (v[j][0] + v[j][1]) + (v[j][2] + v[j][3]);
    mean = wave_sum(s) * (1.f / DM); float s2 = 0.f;
#pragma unroll
    for (int j = 0; j < 4; ++j) { const f32x4 d = v[j] - mean; s2 += (d[0] * d[0] + d[1] * d[1]) + (d[2] * d[2] + d[3] * d[3]); }
    rstd = 1.f / sqrtf(wave_sum(s2) * (1.f / DM) + LN_EPS);
}
__device__ __forceinline__ void ln_phase(const Frame& F, int mode) {
    const int gw = F.vcu * NWAVES + F.wave, NGW = F.G * NWAVES, lane = F.lane;
    const int nrows = mode == 2 ? ROWS_X : MT;
    bf16* HX = (bf16*)(F.ws + WS_HX);
    const float* MOD = (const float*)(F.ws + WS_MOD); const float* MODP = (const float*)(F.ws + WS_MODP);
    for (int task = gw; task < nrows / 32; task += NGW) {
        const int r0 = task * 32; const bool isctx = r0 >= ROWS_X; const int bidx = isctx ? 32 : (r0 >> 11);
        f32x4 sh[4], sc[4], lg[4], lb[4];
        if (mode == 0) {
#pragma unroll
            for (int j = 0; j < 4; ++j) { const int col = 4 * lane + 256 * j; sh[j] = *(const f32x4*)(F.in[5] + col); sc[j] = *(const f32x4*)(F.in[5] + 1024 + col);
                for (int kc = 0; kc < 8; ++kc) { const float* P = MODP + ((size_t)kc * 33 + bidx) * 3072 + col; sh[j] += *(const f32x4*)P; sc[j] += *(const f32x4*)(P + 1024); } }
        } else if (mode == 1) {
#pragma unroll
            for (int j = 0; j < 4; ++j) { const int col = 4 * lane + 256 * j; const float* P = MOD + ((size_t)33 + bidx) * 3072 + col; sh[j] = *(const f32x4*)P; sc[j] = *(const f32x4*)(P + 1024); }
        }
        if (mode >= 1) {
#pragma unroll
            for (int j = 0; j < 4; ++j) { const int col = 4 * lane + 256 * j + (mode - 1) * DM; lg[j] = *(const f32x4*)(F.in[21] + col); lb[j] = *(const f32x4*)(F.in[22] + col); }
        }
        for (int rr = 0; rr < 32; ++rr) {
            const int row = r0 + rr;
            const float* src; float* dstf = nullptr;
            if (mode == 0) src = isctx ? F.in[2] + (size_t)(row - ROWS_X) * DM : F.in[0] + (size_t)row * DM;
            else if (isctx) src = (const float*)(F.ws + WS_CTXR) + (size_t)(row - ROWS_X) * DM;
            else { src = F.out + (size_t)row * DM; dstf = F.out + (size_t)row * DM; }
            f32x4 v[4];
#pragma unroll
            for (int j = 0; j < 4; ++j) v[j] = *((const f32x4*)src + lane + 64 * j);
            float mean, rstd;
            if (mode >= 1) {
                ln_stats(v, mean, rstd);
#pragma unroll
                for (int j = 0; j < 4; ++j) v[j] = (v[j] - mean) * rstd * lg[j] + lb[j];
                if (dstf) {
#pragma unroll
                    for (int j = 0; j < 4; ++j) *((f32x4*)dstf + lane + 64 * j) = v[j];
                }
            }
            if (mode <= 1) {
                ln_stats(v, mean, rstd);
                v2u* o8 = (v2u*)(HX + (size_t)row * DM) + lane;
#pragma unroll
                for (int j = 0; j < 4; ++j) { const f32x4 y = (v[j] - mean) * rstd * (sc[j] + 1.0f) + sh[j]; v2u w; w.x = pk2(y[0], y[1]); w.y = pk2(y[2], y[3]); o8[64 * j] = w; }
            }
        }
    }
}
__device__ __forceinline__ void mod_finalize(const Frame& F) {
    float* MOD = (float*)(F.ws + WS_MOD); const float* MODP = (const float*)(F.ws + WS_MODP);
    for (int idx = F.vcu * 512 + F.tid; idx < 2 * 33 * 3072; idx += F.G * 512) {
        const int layer = idx / (33 * 3072), rem = idx % (33 * 3072), bidx = rem / 3072, n = rem % 3072;
        float s = F.in[5][layer * 3072 + n];
        for (int kc = 0; kc < 8; ++kc) s += MODP[((size_t)(layer * 8 + kc) * 33 + bidx) * 3072 + n];
        MOD[idx] = s;
    }
}

template <int L> struct HyLds { static constexpr int CS = 4 * L + 32, U_OFF = 8 * CS, UP = 528, UBUF = 32 * UP, RED_OFF = U_OFF + 2 * UBUF; };
template <int L> __device__ __forceinline__ void hyena_unit(const Frame& F, int c, const float* hf, const float* hb, const bf16* X1, const bf16* V, const float* cw, const float* cb, bf16* Y) {
    typedef HyLds<L> H;
    LAS unsigned char* lds = F.lds; const int lane = fresh_lane(), w = F.wave, tid = w * 64 + lane;
    float s = 0.f;
    for (int i = tid; i < L; i += 512) { s += fabsf(hf[i]); if (i > 0) s += fabsf(hb[i]); }
    s = wave_sum(s);
    LAS float* red = (LAS float*)(lds + H::RED_OFF);
    if (lane == 0) red[w] = s;
    __syncthreads();
    float tot = 0.f;
#pragma unroll
    for (int i = 0; i < 8; ++i) tot += red[i];
    const float inv = 1.0f / tot;
    for (int idx = tid; idx < 8 * 2 * L; idx += 512) { const int sig = idx / (2 * L), i = idx % (2 * L), n = L - (i + sig);
        float g = 0.f; if (n >= 0 && n < L) g = hf[n]; else if (n < 0 && n > -L) g = hb[-n];
        *(LAS unsigned short*)(lds + sig * H::CS + 2 * i) = (unsigned short)f2bf(g * inv); }
    const float xa = cw[256 + c], xb = cw[768 + 256 + c], xc = cw[1536 + 256 + c], xbias = cb[256 + c];
    const float va = cw[512 + c], vb = cw[768 + 512 + c], vc = cw[1536 + 512 + c], vbias = cb[512 + c];
    constexpr int TPW = L / 256, NCH = L / 256;
    const int r = lane & 31, h = lane >> 5, tw0 = w * 32 * TPW;
    const int sig = (8 - (r & 7)) & 7, rc8 = (r + 7) >> 3;
    const int abase = sig * H::CS + 2 * (L - 8 * rc8 + 8 * h - tw0);
    f32x16 acc[TPW];
#pragma unroll
    for (int i = 0; i < TPW; ++i) acc[i] = f32x16{};
    const int pb = tid >> 4, seg = tid & 15;
    const unsigned prow = (unsigned)(pb * L + 16 * seg);
    v4u rx0, rx1, rv0, rv1; unsigned short hxm, hxp, hvm, hvp;
#define HY_LOAD(S0) do { const int s_ = (S0) + 16 * seg; const unsigned o_ = prow + (unsigned)(S0); rx0 = *(const v4u*)(X1 + o_); rx1 = *(const v4u*)(X1 + o_ + 8u); rv0 = *(const v4u*)(V + o_); rv1 = *(const v4u*)(V + o_ + 8u); \
        hxm = s_ > 0 ? X1[o_ - 1u] : (unsigned short)0; hvm = s_ > 0 ? V[o_ - 1u] : (unsigned short)0; hxp = s_ + 16 < L ? X1[o_ + 16u] : (unsigned short)0; hvp = s_ + 16 < L ? V[o_ + 16u] : (unsigned short)0; } while (0)
    HY_LOAD(0);
    for (int ch = 0; ch < NCH; ++ch) {
        const int S0 = ch * 256, buf = ch & 1;
        {
            float xv[18], vv[18];
            xv[0] = bf1(hxm); vv[0] = bf1(hvm); xv[17] = bf1(hxp); vv[17] = bf1(hvp);
#pragma unroll
            for (int q = 0; q < 4; ++q) { xv[1 + 2 * q] = bflo(rx0[q]); xv[2 + 2 * q] = bfhi(rx0[q]); xv[9 + 2 * q] = bflo(rx1[q]); xv[10 + 2 * q] = bfhi(rx1[q]);
                                          vv[1 + 2 * q] = bflo(rv0[q]); vv[2 + 2 * q] = bfhi(rv0[q]); vv[9 + 2 * q] = bflo(rv1[q]); vv[10 + 2 * q] = bfhi(rv1[q]); }
            float u[16];
#pragma unroll
            for (int j = 0; j < 16; ++j) { const float x1c = xa * xv[j] + xb * xv[j + 1] + xc * xv[j + 2] + xbias, vcv = va * vv[j] + vb * vv[j + 1] + vc * vv[j + 2] + vbias; u[j] = x1c * vcv; }
            v4u o0, o1;
#pragma unroll
            for (int q = 0; q < 4; ++q) { o0[q] = pk2(u[2 * q], u[2 * q + 1]); o1[q] = pk2(u[8 + 2 * q], u[9 + 2 * q]); }
            LAS unsigned char* up = lds + H::U_OFF + buf * H::UBUF + pb * H::UP + seg * 32;
            *(LAS v4u*)up = o0; *(LAS v4u*)(up + 16) = o1;
        }
        if (ch + 1 < NCH) HY_LOAD(S0 + 256);
        __syncthreads();
        const LAS unsigned char* ub = lds + H::U_OFF + buf * H::UBUF + r * H::UP + 16 * h;
        const LAS unsigned char* ab = lds + abase + 2 * S0;
#pragma unroll 1
        for (int kk = 0; kk < 16; ++kk) {
            const bf16x8 bfrag = *(const LAS bf16x8*)(ub + 32 * kk);
#pragma unroll
            for (int i = 0; i < TPW; ++i) { const bf16x8 afrag = *(const LAS bf16x8*)(ab + 32 * kk - 64 * i); acc[i] = __builtin_amdgcn_mfma_f32_32x32x16_bf16(afrag, bfrag, acc[i], 0, 0, 0); }
        }
    }
#undef HY_LOAD
#pragma unroll
    for (int i = 0; i < TPW; ++i)
#pragma unroll
        for (int g = 0; g < 4; ++g) { v2u wv; wv.x = pk2(acc[i][4 * g], acc[i][4 * g + 1]); wv.y = pk2(acc[i][4 * g + 2], acc[i][4 * g + 3]);
            *(v2u*)(Y + (unsigned)(r * L + tw0 + 32 * i + 8 * g + 4 * h)) = wv; }
    __syncthreads();
}
__device__ __forceinline__ void mix_phase(const Frame& F, int layer) {
    using attn_body::attn_unit;
    typedef attn_body::bf16 abf;
    const bf16* PX = (const bf16*)(F.ws + WS_PX); bf16* MG = (bf16*)(F.ws + WS_HX);
    const bf16* KA = (const bf16*)(F.ws + WS_KALL); const bf16* VA = (const bf16*)(F.ws + WS_VALL);
    char* shm = (char*)F.lds;
    const int nun = 2048 + (layer == 0 ? 256 : 0);
#ifndef MIX_NO_ATTN
    for (int U = F.vcu; U < nun; U += F.G) {
        if (U < 2048) {
            const int bk = U >> 5, rem = U & 31, hq = rem >> 3, qb = rem & 7, b = bk >> 1, kvh = bk & 1, hh = kvh * 4 + hq;
            const size_t row0 = (size_t)b * LSEQ + qb * 256;
            attn_unit<8>((const abf*)(PX + row0 * NIN + 1536 + hh * 64), NIN, (const abf*)(KA + (size_t)b * 2304 * 128 + kvh * 64), (const abf*)(VA + (size_t)b * 2304 * 128 + kvh * 64), 128, 36,
                         (abf*)(MG + row0 * DM + 512 + hh * 64), DM, (const abf*)(PX + row0 * NIN + 2304 + hh * 64), NIN, shm, F.wave);
        } else {
            const int uc = U - 2048, b = uc >> 3, hh = uc & 7, kvh = hh >> 2;
            const size_t row0 = (size_t)ROWS_X + b * LCTX;
            attn_unit<8>((const abf*)(PX + row0 * NIN + 1536 + hh * 64), NIN, (const abf*)(KA + ((size_t)b * 2304 + 2048) * 128 + kvh * 64), (const abf*)(VA + ((size_t)b * 2304 + 2048) * 128 + kvh * 64), 128, 4,
                         (abf*)(MG + row0 * DM + 512 + hh * 64), DM, (const abf*)(PX + row0 * NIN + 2304 + hh * 64), NIN, shm, F.wave);
        }
    }
#endif
#ifndef MIX_NO_HY
    const float* cw = F.in[9] + layer * 3 * 768; const float* cb = F.in[10] + layer * 768;
    for (int c = F.vcu; c < 256; c += F.G) {
        const float* HF = (const float*)(F.ws + WS_HF) + (size_t)layer * 512 * 2048;
        hyena_unit<2048>(F, c, HF + (size_t)c * 2048, HF + (size_t)(256 + c) * 2048, (const bf16*)(F.ws + WS_HYT) + (size_t)c * 32 * 2048, (const bf16*)(F.ws + WS_HYT) + (size_t)(256 + c) * 32 * 2048, cw, cb,
                         (bf16*)(F.ws + WS_YHT) + (size_t)c * 32 * 2048);
        if (layer == 0) {
            const float* HFC = (const float*)(F.ws + WS_HF) + (size_t)2 * 512 * 2048;
            hyena_unit<256>(F, c, HFC + (size_t)c * 256, HFC + (size_t)(256 + c) * 256, (const bf16*)(F.ws + WS_HYTC) + (size_t)c * 32 * 256, (const bf16*)(F.ws + WS_HYTC) + (size_t)(256 + c) * 32 * 256, cw, cb,
                            (bf16*)(F.ws + WS_YHTC) + (size_t)c * 32 * 256);
        }
    }
#endif
}

constexpr int MG_VT = 0, MG_P = 528, MG_DT = 41728, MG_YL = 75520, MG_WL = 109312;
__device__ __forceinline__ void merge_phase(const Frame& F, int layer) {
    LAS unsigned char* lds = F.lds; const int tid = F.tid, lane = F.lane, w = F.wave;
    const bf16* PX = (const bf16*)(F.ws + WS_PX); bf16* MG = (bf16*)(F.ws + WS_HX);
    const bf16* PWT = (const bf16*)(F.ws + WS_PWT) + (size_t)layer * 4 * 64 * 64;
    const float* pscale = F.in[8] + layer * 256; const float* cw = F.in[9] + layer * 3 * 768; const float* cb = F.in[10] + layer * 768; const float* hbias = F.in[17] + layer * 256;
    const int nst = (layer == 0 ? MT : ROWS_X) / 64;
    const int cg8 = (tid & 31) * 8;
    { LAS float* WL = (LAS float*)(lds + MG_WL);
      for (int i = tid; i < 3328; i += 512) WL[i] = i < 2304 ? cw[i] : (i < 3072 ? cb[i - 2304] : hbias[i - 3072]); }
    __syncthreads();
    for (int st = F.vcu; st < nst; st += F.G) {
        const int R0 = st * 64; int b, t0, Lq; unsigned seq0; const bf16* YH;
        if (R0 < ROWS_X) { b = R0 >> 11; t0 = R0 & 2047; Lq = LSEQ; seq0 = (unsigned)(b * LSEQ); YH = (const bf16*)(F.ws + WS_YHT); }
        else { const int rc = R0 - ROWS_X; b = rc >> 8; t0 = rc & 255; Lq = LCTX; seq0 = (unsigned)(ROWS_X + b * LCTX); YH = (const bf16*)(F.ws + WS_YHTC); }
        for (int id = tid; id < 79 * 32; id += 512) { const int q = id >> 5, ch = id & 31, p = t0 - 8 + q;
            v4u val = (v4u){0u, 0u, 0u, 0u}; if (p >= 0 && p < Lq) val = *(const v4u*)(PX + ((seq0 + (unsigned)p) * (unsigned)NIN + 8u * ch));
            *(LAS v4u*)(lds + MG_VT + q * MG_P + 16 * ch) = val; }
        { const int c = tid >> 1, hs = tid & 1; const bf16* yp = YH + (unsigned)((c * 32 + b) * Lq + t0 + 32 * hs);
#pragma unroll
            for (int k = 0; k < 4; ++k) { const v4u yv = *(const v4u*)(yp + 8 * k);
#pragma unroll
                for (int q = 0; q < 4; ++q) { *(LAS unsigned short*)(lds + MG_YL + (32 * hs + 8 * k + 2 * q) * MG_P + 2 * c) = (unsigned short)(yv[q] & 0xffffu);
                                              *(LAS unsigned short*)(lds + MG_YL + (32 * hs + 8 * k + 2 * q + 1) * MG_P + 2 * c) = (unsigned short)(yv[q] >> 16); } } }
        __syncthreads();
        { const int col = tid & 255, half = tid >> 8, g = col >> 6, hw = 1 << g;
            const LAS unsigned char* vc = lds + MG_VT + 2 * col;
            const int j0 = 32 * half; float S = 0.f;
            for (int q = j0 + 8 - hw; q < j0 + 8 + hw; ++q) S += bf1(*(const LAS unsigned short*)(vc + q * MG_P));
            for (int j = j0; j < j0 + 32; ++j) {
                const int t = t0 + j; const int lo = max(t - hw, 0), hi = min(t + hw, Lq);
                const float mean = S / (float)(hi - lo);
                const float d = mean - bf1(*(const LAS unsigned short*)(vc + (j + 8) * MG_P));
                *(LAS unsigned short*)(lds + MG_DT + j * MG_P + 2 * col) = (unsigned short)f2bf(d);
                if (j + 1 < j0 + 32) S += bf1(*(const LAS unsigned short*)(vc + (j + 8 + hw) * MG_P)) - bf1(*(const LAS unsigned short*)(vc + (j + 8 - hw) * MG_P));
            } }
        __syncthreads();
        { const int g = w >> 1, rt = w & 1, r = lane & 31, h = lane >> 5;
#pragma unroll
            for (int jt = 0; jt < 2; ++jt) {
                f32x16 acc = f32x16{};
#pragma unroll
                for (int kk = 0; kk < 4; ++kk) {
                    const bf16x8 a = *(const LAS bf16x8*)(lds + MG_DT + (32 * rt + r) * MG_P + 2 * (64 * g + 16 * kk + 8 * h));
                    const bf16x8 bfr = *(const bf16x8*)(PWT + ((size_t)g * 64 + 32 * jt + r) * 64 + 16 * kk + 8 * h);
                    acc = __builtin_amdgcn_mfma_f32_32x32x16_bf16(a, bfr, acc, 0, 0, 0);
                }
                const int col = 64 * g + 32 * jt + r; const float ps = pscale[col];
#pragma unroll
                for (int reg = 0; reg < 16; ++reg) { const int row = 32 * rt + (reg & 3) + 8 * (reg >> 2) + 4 * h; const unsigned grow = (unsigned)(R0 + row);
                    const float gate = bf1(PX[grow * (unsigned)NIN + 256u + col]);
                    MG[grow * (unsigned)DM + col] = (bf16)f2bf(acc[reg] * ps * gate); }
            } }
#pragma unroll
        for (int q = 0; q < 4; ++q) { const int tok = (tid >> 5) + 16 * q; const int t = t0 + tok; const unsigned grow = (unsigned)(R0 + tok);
            const bf16* rowp = PX + (grow * (unsigned)NIN + 512u + cg8);
            v4u x0r[3], x1r[3], vr[3];
#pragma unroll
            for (int j = 0; j < 3; ++j) { const bool ok = (t + j - 1 >= 0) && (t + j - 1 < Lq); const bf16* rp = rowp + (j - 1) * NIN;
                x0r[j] = ok ? *(const v4u*)rp : (v4u){0u, 0u, 0u, 0u}; x1r[j] = ok ? *(const v4u*)(rp + 256) : (v4u){0u, 0u, 0u, 0u}; vr[j] = ok ? *(const v4u*)(rp + 512) : (v4u){0u, 0u, 0u, 0u}; }
            const v4u gr = *(const v4u*)(rowp + 768);
            const v4u yr = *(const LAS v4u*)(lds + MG_YL + tok * MG_P + 2 * cg8);
            v4u o;
#pragma unroll
            for (int hf = 0; hf < 2; ++hf) {
                const LAS float* WL = (const LAS float*)(lds + MG_WL) + cg8 + 4 * hf;
                f32x4 a0 = *(const LAS f32x4*)(WL + 2304), a1 = *(const LAS f32x4*)(WL + 2304 + 256), a2 = *(const LAS f32x4*)(WL + 2304 + 512);
#pragma unroll
                for (int j = 0; j < 3; ++j) { const f32x4 w0 = *(const LAS f32x4*)(WL + j * 768), w1 = *(const LAS f32x4*)(WL + j * 768 + 256), w2 = *(const LAS f32x4*)(WL + j * 768 + 512);
                    const unsigned xa = x0r[j][2 * hf], xb = x0r[j][2 * hf + 1], ya = x1r[j][2 * hf], yb = x1r[j][2 * hf + 1], za = vr[j][2 * hf], zb = vr[j][2 * hf + 1];
                    a0 += w0 * (f32x4){bflo(xa), bfhi(xa), bflo(xb), bfhi(xb)}; a1 += w1 * (f32x4){bflo(ya), bfhi(ya), bflo(yb), bfhi(yb)}; a2 += w2 * (f32x4){bflo(za), bfhi(za), bflo(zb), bfhi(zb)}; }
                const f32x4 hb4 = *(const LAS f32x4*)(WL + 3072);
                const unsigned y0 = yr[2 * hf], y1 = yr[2 * hf + 1], g0 = gr[2 * hf], g1 = gr[2 * hf + 1];
                const f32x4 yv = (f32x4){bflo(y0), bfhi(y0), bflo(y1), bfhi(y1)}, gv = (f32x4){bflo(g0), bfhi(g0), bflo(g1), bfhi(g1)};
                const f32x4 res = a0 * (yv + a1 * a2 * hb4) * gv;
                o[2 * hf] = pk2(res[0], res[1]); o[2 * hf + 1] = pk2(res[2], res[3]); }
            *(v4u*)(MG + (grow * (unsigned)DM + 256u + cg8)) = o; }
        __syncthreads();
    }
}
#ifndef MK_MULTI
#define MK_MULTI 1
#endif
struct Args { const float* in[23]; float* out; unsigned char* ws; int ph_lo, ph_hi; };
constexpr int N_PHASES = 12;

__global__ void __launch_bounds__(NWAVES * 64, 2) mega_fwd(Args args) {
    extern __shared__ __attribute__((aligned(16))) unsigned char lds_raw[];
    Frame F;
    F.lds = (LAS unsigned char*)lds_raw;
    F.G = gridDim.x; { const int bx = blockIdx.x; F.vcu = (F.G % 8 == 0) ? (bx % 8) * (F.G / 8) + bx / 8 : bx; }
    F.in = args.in;
    F.wave = __builtin_amdgcn_readfirstlane((int)threadIdx.x >> 6);
    const int lo = args.ph_lo, hi = args.ph_hi;
#if MK_MULTI
#define GRID_SYNC() do { } while (0)
#else
#define GRID_SYNC() do { __threadfence(); cg::this_grid().sync(); } while (0)
#endif
#ifndef PH_MASK
#define PH_MASK 0xfff
#endif
#define PH_ON(k) ((PH_MASK >> (k)) & 1)
#define IN(k) (lo <= (k) && (k) < hi)
#define SEAM(k) do { if (IN(k) && IN((k) + 1)) GRID_SYNC(); } while (0)
#define FRESH() do { F.lane = fresh_lane(); F.tid = F.wave * 64 + F.lane; F.ws = args.ws; F.out = args.out; } while (0)
    if (IN(0) && PH_ON(0)) { FRESH(); p0a_phase(F); }
    SEAM(0);
    if (IN(1) && PH_ON(1)) { FRESH(); mod_finalize(F); ln_phase(F, 0); }
    SEAM(1);
#pragma unroll 1
    for (int layer = 0; layer < 2; ++layer) {
        const int p0 = 2 + 5 * layer;
        if (IN(p0) && PH_ON(2)) { FRESH();
            pg8::Gemm g{(const pg8::bf16_t*)(F.ws + WS_HX), (const pg8::bf16_t*)(F.ws + WS_WIN) + (size_t)layer * NIN * 1024, MT, NIN, DM};
            pg8::GridOrder S;
            if (layer == 0) S = pg8::GridOrder{MT / 256, NIN / 256, 0, 0, 0, F.G, (int)blockIdx.x};
            else S = pg8::GridOrder{ROWS_X / 256, NIN / 256, ROWS_C / 256, ROWS_X / 256, 8, F.G, (int)blockIdx.x};
            pg8::EpiIn E{(pg8::bf16_t*)(F.ws + WS_PX), (pg8::bf16_t*)(F.ws + WS_KALL), (pg8::bf16_t*)(F.ws + WS_VALL), (pg8::bf16_t*)(F.ws + WS_HYT), (pg8::bf16_t*)(F.ws + WS_HYTC),
                          F.in[18] + layer * 64, F.in[19] + layer * 64, (const float*)(F.ws + WS_ROPE), F.lds + STG_OFF};
            pg8::gemm_phase<pg8::EpiIn, pg8::GridOrder, true, true>(F.lds, g, S, E, F.wave); }
        SEAM(p0);
        if (IN(p0 + 1) && PH_ON(3)) { FRESH(); mix_phase(F, layer); }
        SEAM(p0 + 1);
        if (IN(p0 + 2) && PH_ON(4)) { FRESH(); merge_phase(F, layer); }
        SEAM(p0 + 2);
        if (IN(p0 + 3) && PH_ON(5)) { FRESH();
            pg8::Gemm g{(const pg8::bf16_t*)(F.ws + WS_HX), (const pg8::bf16_t*)(F.ws + WS_WOUT) + (size_t)layer * 1024 * 1024, MT, DM, DM};
            pg8::GridOrder S{(layer == 0 ? MT : ROWS_X) / 256, DM / 256, 0, 0, 0, F.G, (int)blockIdx.x};
            pg8::EpiOut E{layer == 0 ? F.in[0] : F.out, F.in[2], F.out, (float*)(F.ws + WS_CTXR), (const float*)(F.ws + WS_MOD) + (size_t)layer * 33 * 3072};
            pg8::gemm_phase<pg8::EpiOut, pg8::GridOrder, true, true>(F.lds, g, S, E, F.wave); }
        SEAM(p0 + 3);
        if (IN(p0 + 4) && PH_ON(6)) { FRESH(); ln_phase(F, layer + 1); }
        SEAM(p0 + 4);
    }
#undef IN
#undef SEAM
#undef FRESH
}

extern "C" void kernel_launch(void* const* d_in, const int* in_sizes, int n_in, void* d_out, int out_size, void* d_ws, size_t ws_size, hipStream_t stream) {
    static int grid = 0;
    if (grid == 0) {
        if (n_in != 23 || out_size != ROWS_X * DM || ws_size < WS_END) { fprintf(stderr, "kernel_launch: unexpected shapes (n_in %d, out %d, ws %zu)\n", n_in, out_size, ws_size); grid = -1; return; }
        int dev = 0, cus = 0, per_cu = 0;
        hipGetDevice(&dev); hipDeviceGetAttribute(&cus, hipDeviceAttributeMultiprocessorCount, dev);
        hipFuncSetAttribute((const void*)mega_fwd, hipFuncAttributeMaxDynamicSharedMemorySize, LDS_BYTES);
        hipOccupancyMaxActiveBlocksPerMultiprocessor(&per_cu, (const void*)mega_fwd, NWAVES * 64, LDS_BYTES);
        (void)hipGetLastError();
        if (per_cu < 1) { fprintf(stderr, "kernel_launch: occupancy query reports %d blocks per CU\n", per_cu); per_cu = 1; }
        grid = cus;
    }
    if (grid < 0) return;
    Args a{};
    for (int i = 0; i < 23; ++i) a.in[i] = (const float*)d_in[i];
    a.out = (float*)d_out; a.ws = (unsigned char*)d_ws;
#if MK_MULTI
    for (int ph = 0; ph < N_PHASES; ++ph) { a.ph_lo = ph; a.ph_hi = ph + 1; hipLaunchKernelGGL(mega_fwd, dim3(grid), dim3(NWAVES * 64), LDS_BYTES, stream, a); }
#else
    a.ph_lo = 0; a.ph_hi = N_PHASES;
    void* kargs[] = {&a};
    hipError_t e = hipLaunchCooperativeKernel((const void*)mega_fwd, dim3(grid), dim3(NWAVES * 64), kargs, LDS_BYTES, stream);
    if (e != hipSuccess) fprintf(stderr, "cooperative launch failed: %s (grid %d)\n", hipGetErrorString(e), grid);
#endif
}
```

```cpp
#include <hip/hip_runtime.h>
#include <hip/hip_cooperative_groups.h>
#include <hip/hip_bf16.h>
#include <cstdio>
#include <cstdint>
#include <cmath>
namespace cg = cooperative_groups;
#ifndef MK_CHECK
#define MK_CHECK 0
#endif
__device__ __forceinline__ int fresh_lane() { int l; asm volatile("v_mbcnt_lo_u32_b32 %0, -1, 0\n\tv_mbcnt_hi_u32_b32 %0, -1, %0" : "=v"(l)); return l; }
__device__ __forceinline__ float xor16_f(float v) { return __int_as_float(__builtin_amdgcn_ds_swizzle(__float_as_int(v), 0x401F)); }
__device__ __forceinline__ float sum_xor32(float v) { auto r = __builtin_amdgcn_permlane32_swap(__float_as_uint(v), __float_as_uint(v), false, false); return __uint_as_float(r[0]) + __uint_as_float(r[1]); }
__device__ __forceinline__ float max_xor32(float v) { auto r = __builtin_amdgcn_permlane32_swap(__float_as_uint(v), __float_as_uint(v), false, false); return fmaxf(__uint_as_float(r[0]), __uint_as_float(r[1])); }
#define DPP_F(v, ctrl) __int_as_float(__builtin_amdgcn_update_dpp(0, __float_as_int(v), (ctrl), 0xf, 0xf, true))
__device__ __forceinline__ float wave_sum(float v) {
    v += DPP_F(v, 0xB1); v += DPP_F(v, 0x4E); v += DPP_F(v, 0x141); v += DPP_F(v, 0x140);
    v += xor16_f(v); return sum_xor32(v);
}
__device__ __forceinline__ float wave_max(float v) {
    v = fmaxf(v, DPP_F(v, 0xB1)); v = fmaxf(v, DPP_F(v, 0x4E)); v = fmaxf(v, DPP_F(v, 0x141)); v = fmaxf(v, DPP_F(v, 0x140));
    v = fmaxf(v, xor16_f(v)); return max_xor32(v);
}
namespace pg8 {
#define PG8_LAS __attribute__((address_space(3)))
typedef unsigned short bf16_t;
typedef short bf16x8 __attribute__((ext_vector_type(8)));
typedef float f32x4 __attribute__((ext_vector_type(4)));
typedef unsigned u32x4 __attribute__((ext_vector_type(4)));
constexpr int BM = 256, BK = 64, HALF = 128, HTB = HALF * BK * 2  , STAGE_BYTES = 8 * HTB, NXCD = 8, WGM = 8;

__host__ __device__ __forceinline__ int lds_byte(int r, int c) { const int st = (r >> 4) * 2 + (c >> 5), rr = r & 15, cc = c & 31, ob = rr * 64 + cc * 2; return st * 1024 + (ob ^ (((ob >> 9) & 1) << 5)); }
__host__ __device__ __forceinline__ void stage_rc(int b, int& R, int& C) { const int st = b / 1024, sb = b % 1024, swz = sb ^ (((sb >> 9) & 1) << 5); R = (st >> 1) * 16 + swz / 64; C = (st & 1) * 32 + (swz % 64) / 2; }
__host__ __device__ __forceinline__ int perm32(int rho) { const int n = rho >> 4, i = rho & 15; return 8 * (i >> 2) + 4 * n + (i & 3); }

struct Unit { int pm, pn; };
struct Gemm { const bf16_t* A; const bf16_t* Bt; int M, N, K; };

__device__ __forceinline__ void map_linear(int wgid, int nM, int nN, Unit& u) {
    const int nwg = nM * nN;
    { const int q = nwg / NXCD, r = nwg % NXCD, xcd = wgid % NXCD, off = wgid / NXCD; wgid = (xcd < r ? xcd * (q + 1) : r * (q + 1) + (xcd - r) * q) + off; }
    const int nig = WGM * nN, gid = wgid / nig, fm = gid * WGM, gsz = (nM - fm) < WGM ? (nM - fm) : WGM;
    u.pm = fm + ((wgid % nig) % gsz); u.pn = (wgid % nig) / gsz;
}
struct GridOrder {
    int nM, nN, extra, extra_pm0, extra_pn, G, c;
    __device__ __forceinline__ bool next(int i, Unit& u) const {
        const long L = (long)i * G + c; const int nwg = nM * nN;
        if (L < nwg) { map_linear((int)L, nM, nN, u); return true; }
        if (L < nwg + extra) { u.pm = extra_pm0 + (int)(L - nwg); u.pn = extra_pn; return true; }
        return false;
    }
    __device__ __forceinline__ void a_ready(const Unit&) const {}
    __device__ __forceinline__ void done(const Unit&) const {}
};

__device__ __forceinline__ unsigned cvt_pk_bf16(float lo, float hi) { unsigned r; asm volatile("v_cvt_pk_bf16_f32 %0, %1, %2" : "=v"(r) : "v"(lo), "v"(hi)); return r; }
__device__ __forceinline__ float silu_f(float x) { return x * __builtin_amdgcn_rcpf(1.0f + __expf(-x)); }
typedef unsigned u32x2 __attribute__((ext_vector_type(2)));
constexpr int NINW = 2816, KVP = 128, KVROWS = 2304;
constexpr float QSCALE = 0.125f * 1.4426950408889634f;

struct EpiIn {
    static constexpr bool PERM = false, AFTER_DRAIN = false;
    bf16_t* PX; bf16_t* KALL; bf16_t* VALL; bf16_t* HYT; bf16_t* HYTC; const float* qn; const float* kn; const float* rope; PG8_LAS unsigned char* stg0;
    __device__ __forceinline__ void operator()(const f32x4 (&acc)[2][2][4][2], const Unit& u, int wr, int wc, int fr, int fq) const {
        asm volatile("" : "+v"(fr), "+v"(fq));
        const int pn = u.pn; const bool isctx = u.pm >= 256;
        const int rowt = u.pm * 256 + wr * 64 + fr;
        if (pn >= 6 && pn <= 8) {
            const bool isv = (pn == 8) && (wc >= 2); const bool isq = pn != 8;
            const float* gw = isq ? qn : kn;
            const int ax = fq >> 1, d0 = 32 * ax + 8 * (fq & 1);
            f32x4 g[2][2];
#pragma unroll
            for (int bj = 0; bj < 2; ++bj)
#pragma unroll
                for (int n = 0; n < 2; ++n) g[bj][n] = *(const f32x4*)(gw + d0 + 16 * bj + 4 * n);
            const int bb = isctx ? (u.pm - 256) : (u.pm >> 3);
#pragma unroll
            for (int ai = 0; ai < 2; ++ai)
#pragma unroll
                for (int m = 0; m < 4; ++m) {
                    const int row = rowt + 128 * ai + 16 * m;
                    const int t = isctx ? (row & 255) : (row & 2047);
                    f32x4 x[2][2];
#pragma unroll
                    for (int bj = 0; bj < 2; ++bj)
#pragma unroll
                        for (int n = 0; n < 2; ++n) x[bj][n] = acc[ai][bj][m][n];
                    if (!isv) {
                        float ss = 0.f;
#pragma unroll
                        for (int bj = 0; bj < 2; ++bj)
#pragma unroll
                            for (int n = 0; n < 2; ++n) ss += (x[bj][n][0] * x[bj][n][0] + x[bj][n][1] * x[bj][n][1]) + (x[bj][n][2] * x[bj][n][2] + x[bj][n][3] * x[bj][n][3]);
                        ss += xor16_f(ss); ss = sum_xor32(ss);
                        const float rs = 1.0f / sqrtf(ss * (1.0f / 64.0f) + 1e-6f) * (isq ? QSCALE : 1.0f);
#pragma unroll
                        for (int bj = 0; bj < 2; ++bj)
#pragma unroll
                            for (int n = 0; n < 2; ++n) x[bj][n] = x[bj][n] * rs * g[bj][n];
                        if (!isctx) {
                            const int pos = ax == 0 ? (t >> 6) : (t & 63);
                            const float* rp = rope + (pos * 16 + 8 * (fq & 1)) * 2;
#pragma unroll
                            for (int n = 0; n < 2; ++n) { const f32x4 cs0 = *(const f32x4*)(rp + 8 * n), cs1 = *(const f32x4*)(rp + 8 * n + 4);
                                const float cc[4] = {cs0[0], cs0[2], cs1[0], cs1[2]}, sn[4] = {cs0[1], cs0[3], cs1[1], cs1[3]};
#pragma unroll
                                for (int e = 0; e < 4; ++e) { const float a = x[0][n][e], b = x[1][n][e]; x[0][n][e] = a * cc[e] - b * sn[e]; x[1][n][e] = a * sn[e] + b * cc[e]; } }
                        }
                    }
                    bf16_t* dst;
                    if (isq) dst = PX + (size_t)row * NINW + 1536 + 256 * (pn - 6) + 64 * wc + d0;
                    else { const int tk = isctx ? (2048 + t) : t; dst = (isv ? VALL : KALL) + ((size_t)bb * KVROWS + tk) * KVP + 64 * (wc & 1) + d0; }
#pragma unroll
                    for (int bj = 0; bj < 2; ++bj) { u32x4 w; w.x = cvt_pk_bf16(x[bj][0][0], x[bj][0][1]); w.y = cvt_pk_bf16(x[bj][0][2], x[bj][0][3]); w.z = cvt_pk_bf16(x[bj][1][0], x[bj][1][1]); w.w = cvt_pk_bf16(x[bj][1][2], x[bj][1][3]);
                        *(u32x4*)(dst + 16 * bj) = w; }
                    asm volatile("" ::: "memory");
                }
        } else {
            const bool dosilu = false;
            const bool dotr = (pn == 3) || (pn == 4);
            const int wid = wr * 4 + wc;
            PG8_LAS unsigned char* stg = stg0 + wid * 2304;
            bf16_t* hyt; int Lq, s0, bb;
            if (isctx) { hyt = HYTC + (size_t)(pn - 3) * 256 * 32 * 256; Lq = 256; s0 = 0; bb = u.pm - 256; }
            else { hyt = HYT + (size_t)(pn - 3) * 256 * 32 * 2048; Lq = 2048; s0 = (u.pm & 7) * 256; bb = u.pm >> 3; }
#pragma unroll
            for (int ai = 0; ai < 2; ++ai)
#pragma unroll
                for (int bj = 0; bj < 2; ++bj) {
                    f32x4 v[4][2];
#pragma unroll
                    for (int m = 0; m < 4; ++m)
#pragma unroll
                        for (int n = 0; n < 2; ++n) { v[m][n] = acc[ai][bj][m][n];
                            if (dosilu) { v[m][n][0] = silu_f(v[m][n][0]); v[m][n][1] = silu_f(v[m][n][1]); v[m][n][2] = silu_f(v[m][n][2]); v[m][n][3] = silu_f(v[m][n][3]); } }
                    if (!dotr)
#pragma unroll
                    for (int m = 0; m < 4; ++m) { const int row = rowt + 128 * ai + 16 * m;
                        u32x4 w; w.x = cvt_pk_bf16(v[m][0][0], v[m][0][1]); w.y = cvt_pk_bf16(v[m][0][2], v[m][0][3]); w.z = cvt_pk_bf16(v[m][1][0], v[m][1][1]); w.w = cvt_pk_bf16(v[m][1][2], v[m][1][3]);
                        *(u32x4*)(PX + (size_t)row * NINW + 256 * pn + 128 * bj + 32 * wc + 8 * fq) = w; }
                    if (dotr) {
                        const int lane = fq * 16 + fr;
#pragma unroll
                        for (int n = 0; n < 2; ++n) {
#pragma unroll
                            for (int m = 0; m < 4; ++m)
#pragma unroll
                                for (int e = 0; e < 4; ++e) { const unsigned bits = cvt_pk_bf16(v[m][n][e], 0.f); *(PG8_LAS unsigned short*)(stg + (4 * fq + e) * 144 + (16 * m + fr) * 2) = (unsigned short)bits; }
#pragma unroll
                            for (int k = 0; k < 2; ++k) { const int piece = lane + 64 * k, cs = piece >> 3, chunk = piece & 7;
                                const u32x4 w = *(const PG8_LAS u32x4*)(stg + cs * 144 + chunk * 16);
                                const int ch = 128 * bj + 32 * wc + 8 * (cs >> 2) + 4 * n + (cs & 3);
                                *(u32x4*)(hyt + ((size_t)ch * 32 + bb) * Lq + s0 + 128 * ai + 64 * wr + 8 * chunk) = w; }
                        }
                    }
                    asm volatile("" ::: "memory");
                }
        }
    }
};

constexpr float DN_ALPHA = 1.4142135623730951f;
struct EpiOut {
    static constexpr bool PERM = true, AFTER_DRAIN = false;
    bf16_t* GY; const float* gate;
    __device__ __forceinline__ void operator()(const f32x4 (&acc)[2][2][4][2], const Unit& u, int wr, int wc, int fr, int fq) const {
        asm volatile("" : "+v"(fr), "+v"(fq));
        const bool isctx = u.pm >= 256; const int bb = isctx ? 32 : (u.pm >> 3);
        const int rowt = u.pm * 256 + wr * 64 + fr, col0 = u.pn * 256 + wc * 32 + 8 * fq;
        f32x4 gv[2][2];
#pragma unroll
        for (int bj = 0; bj < 2; ++bj)
#pragma unroll
            for (int n = 0; n < 2; ++n) gv[bj][n] = *(const f32x4*)(gate + (size_t)bb * 3072 + 2048 + col0 + 128 * bj + 4 * n);
#pragma unroll
        for (int ai = 0; ai < 2; ++ai)
#pragma unroll
            for (int m = 0; m < 4; ++m) { bf16_t* rowp = GY + (size_t)(rowt + 128 * ai + 16 * m) * 1024 + col0;
#pragma unroll
                for (int bj = 0; bj < 2; ++bj) { const f32x4 v0 = acc[ai][bj][m][0] * gv[bj][0], v1 = acc[ai][bj][m][1] * gv[bj][1];
                    u32x4 w; w.x = cvt_pk_bf16(v0[0], v0[1]); w.y = cvt_pk_bf16(v0[2], v0[3]); w.z = cvt_pk_bf16(v1[0], v1[1]); w.w = cvt_pk_bf16(v1[2], v1[3]);
                    *(u32x4*)(rowp + 128 * bj) = w; } }
    }
};


struct EpiDummy {
    static constexpr bool PERM = true, AFTER_DRAIN = false;
    bf16_t* O; int ldc;
    __device__ __forceinline__ void operator()(const f32x4 (&acc)[2][2][4][2], const Unit& u, int wr, int wc, int fr, int fq) const {
        asm volatile("" : "+v"(fr), "+v"(fq));
        const int row0 = u.pm * 256 + wr * 64 + fr, col0 = u.pn * 256 + wc * 32 + 8 * fq;
#pragma unroll
        for (int ai = 0; ai < 2; ++ai)
#pragma unroll
            for (int m = 0; m < 4; ++m) { bf16_t* rowp = O + (size_t)(row0 + ai * 128 + m * 16) * ldc + col0;
#pragma unroll
                for (int bj = 0; bj < 2; ++bj) { const f32x4 v0 = acc[ai][bj][m][0], v1 = acc[ai][bj][m][1];
                    u32x4 w; w.x = cvt_pk_bf16(v0[0], v0[1]); w.y = cvt_pk_bf16(v0[2], v0[3]); w.z = cvt_pk_bf16(v1[0], v1[1]); w.w = cvt_pk_bf16(v1[2], v1[3]);
#ifdef DUMMY_NOSTORE
                    asm volatile("" :: "v"(w.x), "v"(w.y), "v"(w.z), "v"(w.w)); (void)rowp; } }
#else
                    *(u32x4*)(rowp + 128 * bj) = w; } }
#endif
    }
};
template <class Epi, class Sched, bool ALIGN_EPI = false, bool SP2 = false>
__device__ __forceinline__ void gemm_phase(PG8_LAS unsigned char* lds, const Gemm g, const Sched& S, const Epi& E, int wave0) {
    int wid_ = wave0; asm volatile("" : "+s"(wid_));
    const int lane = fresh_lane(), wid = wid_, tid = wid * 64 + lane, wr = wid >> 2, wc = wid & 3, fr = lane & 15, fq = lane >> 4;
    const int K = g.K, nt = K / BK;
    unsigned voffA[2], voffB[2];
#pragma unroll
    for (int i = 0; i < 2; ++i) { int R, C; stage_rc(tid * 16 + i * 8192, R, C); const int Rb = Epi::PERM ? ((R & ~31) + perm32(R & 31)) : R;
        voffA[i] = (unsigned)(R * K + C) * 2u; voffB[i] = (unsigned)(Rb * K + C) * 2u; }
    const size_t kstep = (size_t)(BK * 2);
    const size_t hstep = (size_t)HALF * K * 2;
    const size_t tstep = 2 * hstep;
    const unsigned ldsw = (unsigned)wid * 1024u;
    const int aoff = lds_byte(wr * 64 + fr, fq * 8), boff = lds_byte(wc * 32 + fr, fq * 8);
#define PG8_SA(b, h) (((b) * 2 + (h)) * HTB)
#define PG8_SB(b, h) ((4 + (b) * 2 + (h)) * HTB)
#define PG8_STAGE(bufoff, gbase, voff) do { _Pragma("unroll") for (int _i = 0; _i < 2; ++_i) \
        __builtin_amdgcn_global_load_lds((const unsigned*)((const char*)(gbase) + (voff)[_i]), (PG8_LAS unsigned*)(lds + (bufoff) + ldsw + _i * 8192), 16, 0, 0); } while (0)
#define PG8_LDA(dst, b, h) do { _Pragma("unroll") for (int m = 0; m < 4; ++m) _Pragma("unroll") for (int k = 0; k < 2; ++k) dst[m][k] = *(const PG8_LAS bf16x8*)(lds + PG8_SA(b, h) + aoff + m * 2048 + k * 1024); } while (0)
#define PG8_LDB(dst, b, h) do { _Pragma("unroll") for (int n = 0; n < 2; ++n) _Pragma("unroll") for (int k = 0; k < 2; ++k) dst[n][k] = *(const PG8_LAS bf16x8*)(lds + PG8_SB(b, h) + boff + n * 2048 + k * 1024); } while (0)
#define PG8_MMA(ai, bj, At, Bt) do { __builtin_amdgcn_s_setprio(1); _Pragma("unroll") for (int m = 0; m < 4; ++m) _Pragma("unroll") for (int n = 0; n < 2; ++n) _Pragma("unroll") for (int k = 0; k < 2; ++k) \
        acc[ai][bj][m][n] = __builtin_amdgcn_mfma_f32_16x16x32_bf16(Bt[n][k], At[m][k], acc[ai][bj][m][n], 0, 0, 0); __builtin_amdgcn_s_setprio(0); } while (0)
#define PG8_WAIT_V(n) asm volatile("s_waitcnt vmcnt(" #n ")" ::: "memory")
#define PG8_WAIT_L(n) asm volatile("s_waitcnt lgkmcnt(" #n ")" ::: "memory")
#define PG8_BAR __builtin_amdgcn_s_barrier()
#define PG8_SCHED __builtin_amdgcn_sched_barrier(0)
    Unit cur, nxt; int ui = 0;
    if (!S.next(0, cur)) return;
    f32x4 acc[2][2][4][2];
#pragma unroll
    for (int a = 0; a < 2; ++a)
#pragma unroll
        for (int b = 0; b < 2; ++b)
#pragma unroll
            for (int m = 0; m < 4; ++m)
#pragma unroll
                for (int n = 0; n < 2; ++n) acc[a][b][m][n] = (f32x4){0.f, 0.f, 0.f, 0.f};
    bf16x8 At[4][2], B0[2][2], B1[2][2];
    const char* cA = (const char*)g.A + (size_t)cur.pm * tstep; const char* cB = (const char*)g.Bt + (size_t)cur.pn * tstep;
    S.a_ready(cur);
    if constexpr (SP2) {
        PG8_STAGE(PG8_SB(0, 0), cB, voffB); PG8_STAGE(PG8_SB(0, 1), cB + hstep, voffB); PG8_STAGE(PG8_SA(0, 0), cA, voffA); PG8_STAGE(PG8_SA(0, 1), cA + hstep, voffA);
        if (wr == 1) PG8_BAR;
        PG8_WAIT_V(2); PG8_BAR;
        PG8_STAGE(PG8_SB(1, 0), cB + kstep, voffB); PG8_STAGE(PG8_SA(1, 0), cA + kstep, voffA); PG8_STAGE(PG8_SB(1, 1), cB + hstep + kstep, voffB);
        PG8_WAIT_V(6); PG8_BAR;
    } else {
        PG8_STAGE(PG8_SB(0, 0), cB, voffB); PG8_STAGE(PG8_SA(0, 0), cA, voffA); PG8_STAGE(PG8_SB(0, 1), cB + hstep, voffB); PG8_STAGE(PG8_SA(0, 1), cA + hstep, voffA);
        if (wr == 1) PG8_BAR;
        PG8_WAIT_V(4); PG8_BAR;
        PG8_STAGE(PG8_SB(1, 0), cB + kstep, voffB); PG8_STAGE(PG8_SA(1, 0), cA + kstep, voffA); PG8_STAGE(PG8_SB(1, 1), cB + hstep + kstep, voffB);
        PG8_WAIT_V(6); PG8_BAR;
    }
    for (;;) {
        const bool has_next = S.next(ui + 1, nxt);
        const char* nA = has_next ? (const char*)g.A + (size_t)nxt.pm * tstep : cA; const char* nB = has_next ? (const char*)g.Bt + (size_t)nxt.pn * tstep : cB;
        for (int t = 0; t < nt; t += 2) {
            const bool last = (t == nt - 2);
            const char* a1 = cA + (size_t)(t + 1) * kstep;
            const char* a2 = last ? nA : cA + (size_t)(t + 2) * kstep; const char* b2 = last ? nB : cB + (size_t)(t + 2) * kstep;
            const char* a3 = a2 + kstep; const char* b3 = b2 + kstep;
            if (last && has_next) S.a_ready(nxt);
            if constexpr (SP2) {
            PG8_LDB(B0, 0, 0); PG8_LDB(B1, 0, 1); PG8_SCHED; PG8_LDA(At, 0, 0); PG8_STAGE(PG8_SA(1, 1), a1 + hstep, voffA);
            PG8_WAIT_V(8); PG8_WAIT_L(0); PG8_BAR; PG8_MMA(0, 0, At, B0); PG8_MMA(0, 1, At, B1); PG8_BAR; PG8_SCHED;
            PG8_LDA(At, 0, 1); PG8_STAGE(PG8_SB(0, 0), b2, voffB); PG8_STAGE(PG8_SB(0, 1), b2 + hstep, voffB); PG8_STAGE(PG8_SA(0, 0), a2, voffA);
            PG8_WAIT_V(8); PG8_WAIT_L(0); PG8_BAR; PG8_MMA(1, 0, At, B0); PG8_MMA(1, 1, At, B1); PG8_BAR; PG8_SCHED;
            PG8_LDB(B0, 1, 0); PG8_LDB(B1, 1, 1); PG8_SCHED; PG8_LDA(At, 1, 0); PG8_STAGE(PG8_SA(0, 1), a2 + hstep, voffA);
            PG8_WAIT_V(8); PG8_WAIT_L(0); PG8_BAR; PG8_MMA(0, 0, At, B0); PG8_MMA(0, 1, At, B1); PG8_BAR; PG8_SCHED;
            PG8_LDA(At, 1, 1); PG8_STAGE(PG8_SB(1, 0), b3, voffB); PG8_STAGE(PG8_SB(1, 1), b3 + hstep, voffB); PG8_STAGE(PG8_SA(1, 0), a3, voffA);
            PG8_WAIT_V(8); PG8_WAIT_L(0); PG8_BAR; PG8_MMA(1, 0, At, B0); PG8_MMA(1, 1, At, B1); PG8_BAR; PG8_SCHED;
            } else {
            PG8_LDB(B0, 0, 0); PG8_SCHED; PG8_LDA(At, 0, 0); PG8_STAGE(PG8_SA(1, 1), a1 + hstep, voffA);
            PG8_WAIT_L(8); PG8_BAR; PG8_WAIT_L(0); PG8_MMA(0, 0, At, B0); PG8_BAR; PG8_SCHED;
            PG8_LDB(B1, 0, 1); PG8_STAGE(PG8_SB(0, 0), b2, voffB);
            PG8_BAR; PG8_WAIT_L(0); PG8_MMA(0, 1, At, B1); PG8_BAR;
            PG8_LDA(At, 0, 1); PG8_STAGE(PG8_SA(0, 0), a2, voffA);
            PG8_BAR; PG8_WAIT_L(0); PG8_MMA(1, 0, At, B0); PG8_BAR; PG8_SCHED;
            PG8_STAGE(PG8_SB(0, 1), b2 + hstep, voffB);
            PG8_WAIT_V(6); PG8_BAR; PG8_MMA(1, 1, At, B1); PG8_BAR;
            PG8_LDB(B0, 1, 0); PG8_SCHED; PG8_LDA(At, 1, 0); PG8_STAGE(PG8_SA(0, 1), a2 + hstep, voffA);
            PG8_WAIT_L(8); PG8_BAR; PG8_WAIT_L(0); PG8_MMA(0, 0, At, B0); PG8_BAR; PG8_SCHED;
            PG8_LDB(B1, 1, 1); PG8_STAGE(PG8_SB(1, 0), b3, voffB);
            PG8_BAR; PG8_WAIT_L(0); PG8_MMA(0, 1, At, B1); PG8_BAR;
            PG8_LDA(At, 1, 1); PG8_STAGE(PG8_SA(1, 0), a3, voffA);
            PG8_BAR; PG8_WAIT_L(0); PG8_MMA(1, 0, At, B0); PG8_BAR; PG8_SCHED;
            PG8_STAGE(PG8_SB(1, 1), b3 + hstep, voffB);
            PG8_WAIT_V(6); PG8_BAR; PG8_MMA(1, 1, At, B1); PG8_BAR;
            }
        }
        if constexpr (ALIGN_EPI) { if (wr == 0) PG8_BAR; }
        if constexpr (!Epi::AFTER_DRAIN) { E(acc, cur, wr, wc, fr, fq); S.done(cur); }
        if (!has_next) break;
#pragma unroll
        for (int a = 0; a < 2; ++a)
#pragma unroll
            for (int b = 0; b < 2; ++b)
#pragma unroll
                for (int m = 0; m < 4; ++m)
#pragma unroll
                    for (int n = 0; n < 2; ++n) acc[a][b][m][n] = (f32x4){0.f, 0.f, 0.f, 0.f};
        cur = nxt; cA = nA; cB = nB; ++ui;
        if constexpr (ALIGN_EPI) { if (wr == 1) PG8_BAR; }
    }
    PG8_WAIT_V(0);
    if constexpr (!ALIGN_EPI) { if (wr == 0) PG8_BAR; }
    PG8_BAR;
    if constexpr (Epi::AFTER_DRAIN) { E.fused(acc, cur, wr, wc, fr, fq, lds, wid, lane); S.done(cur); }
#undef PG8_SA
#undef PG8_SB
#undef PG8_STAGE
#undef PG8_LDA
#undef PG8_LDB
#undef PG8_MMA
#undef PG8_WAIT_V
#undef PG8_WAIT_L
#undef PG8_BAR
#undef PG8_SCHED
}
}
#define ATTN_STORE16(p,v) (*(u32x4*)(p)=(v))
namespace attn_body {
using bf16=__hip_bfloat16;
using bf16x8=__attribute__((ext_vector_type(8)))short;
using s16x4=__attribute__((ext_vector_type(4)))short;
using f32x16=__attribute__((ext_vector_type(16)))float;
using u32x4=__attribute__((ext_vector_type(4)))unsigned;
constexpr int D=64;
constexpr int NW=8,QBLK=32,QB=QBLK*NW,KVBLK=64;
__device__ __forceinline__ int crow(int r,int hi){return (r&3)+8*(r>>2)+4*hi;}
#define SBAR() __builtin_amdgcn_sched_barrier(0)

constexpr int NSLOT=3, SLOTB=8192;
constexpr int LDS_K=0, LDS_V=NSLOT*SLOTB, LDS_WS=2*NSLOT*SLOTB, LDS_OST=LDS_WS+NW*64*4, LDS_BYTES=LDS_OST+NW*4096;
constexpr float C2=0.125f*1.4426950408889634f;
__device__ __forceinline__ void glds16(const void*gsrc,unsigned lds_dst){unsigned keep;
  asm volatile("s_mov_b32 %0, m0\n\ts_mov_b32 m0, %2\n\ts_nop 0\n\tglobal_load_lds_dwordx4 %1, off\n\ts_mov_b32 m0, %0":"=&s"(keep):"v"(gsrc),"s"(lds_dst):"memory");}
__device__ __forceinline__ float max3f(float a,float b,float c){float r;asm("v_max3_f32 %0, %1, %2, %3":"=v"(r):"v"(a),"v"(b),"v"(c));return r;}
__device__ __forceinline__ float max2f(float a,float b){float r;asm("v_max_f32_e32 %0, %1, %2":"=v"(r):"v"(a),"v"(b));return r;}
__device__ __forceinline__ float fadd_s(float a,float b){float r;asm("v_add_f32_e32 %0, %1, %2":"=v"(r):"v"(a),"v"(b));return r;}
__device__ __forceinline__ float fsub_s(float a,float b){float r;asm("v_sub_f32_e32 %0, %1, %2":"=v"(r):"v"(a),"v"(b));return r;}
typedef float f32x2_t __attribute__((ext_vector_type(2))); typedef __bf16 bf16x2_t __attribute__((ext_vector_type(2)));
__device__ __forceinline__ unsigned cvtpk_s(float lo,float hi){f32x2_t v={lo,hi};bf16x2_t b=__builtin_convertvector(v,bf16x2_t);return __builtin_bit_cast(unsigned,b);}
#define WAIT_BAR(N) asm volatile("s_waitcnt vmcnt(" #N ") lgkmcnt(0)\n\ts_barrier":::"memory")

__device__ __forceinline__ void qkt(f32x16&p0,f32x16&p1,const char*Kslot,const bf16x8*qr,const f32x16&negm,int r32,int hi){
  const char*kb=Kslot+hi*1024+r32*16;
  #pragma unroll
  for(int d0=0;d0<4;++d0){
    const bf16x8 b0=*reinterpret_cast<const bf16x8*>(kb+d0*2048);
    const bf16x8 b1=*reinterpret_cast<const bf16x8*>(kb+d0*2048+512);
    if(d0==0){p0=__builtin_amdgcn_mfma_f32_32x32x16_bf16(b0,qr[0],negm,0,0,0);p1=__builtin_amdgcn_mfma_f32_32x32x16_bf16(b1,qr[0],negm,0,0,0);}
    else{p0=__builtin_amdgcn_mfma_f32_32x32x16_bf16(b0,qr[d0],p0,0,0,0);p1=__builtin_amdgcn_mfma_f32_32x32x16_bf16(b1,qr[d0],p1,0,0,0);}}
}
typedef __attribute__((address_space(3))) const char* lds_cptr;
typedef short v4i16_t __attribute__((ext_vector_type(4)));
__device__ __forceinline__ void kload8(bf16x8*kf,lds_cptr kp){
  kf[0]=*(const __attribute__((address_space(3))) bf16x8*)(kp);      kf[1]=*(const __attribute__((address_space(3))) bf16x8*)(kp+512);
  kf[2]=*(const __attribute__((address_space(3))) bf16x8*)(kp+2048); kf[3]=*(const __attribute__((address_space(3))) bf16x8*)(kp+2560);
  kf[4]=*(const __attribute__((address_space(3))) bf16x8*)(kp+4096); kf[5]=*(const __attribute__((address_space(3))) bf16x8*)(kp+4608);
  kf[6]=*(const __attribute__((address_space(3))) bf16x8*)(kp+6144); kf[7]=*(const __attribute__((address_space(3))) bf16x8*)(kp+6656);
}
__device__ __forceinline__ void kload2(bf16x8*kf,lds_cptr kp,int j){ kf[2*j]=*(const __attribute__((address_space(3))) bf16x8*)(kp+j*2048); kf[2*j+1]=*(const __attribute__((address_space(3))) bf16x8*)(kp+j*2048+512); }
__device__ __forceinline__ s16x4 vtr(lds_cptr p){ return __builtin_bit_cast(s16x4,__builtin_amdgcn_ds_read_tr16_b64_v4i16((__attribute__((address_space(3))) v4i16_t*)p)); }
__device__ __forceinline__ float rowmax(const f32x16&p0,const f32x16&p1){
  float a=max3f(p0[0],p0[1],p1[0]),b=max3f(p0[2],p0[3],p1[1]);a=max3f(a,p1[2],p1[3]);
  #pragma unroll
  for(int r=4;r<16;r+=4){a=max3f(a,p0[r],p0[r+1]);b=max3f(b,p0[r+2],p0[r+3]);a=max3f(a,p1[r],p1[r+1]);b=max3f(b,p1[r+2],p1[r+3]);}
  const float m=max2f(a,b);
  auto rr=__builtin_amdgcn_permlane32_swap(__float_as_uint(m),__float_as_uint(m),false,false);
  return max2f(__uint_as_float(rr[0]),__uint_as_float(rr[1]));
}
__device__ __forceinline__ void pv(f32x16*o,int vb,bf16x8 pa0,bf16x8 pa1,bf16x8 pa2,bf16x8 pa3){
  #pragma unroll
  for(int d0=0;d0<2;++d0){s16x4 lo[4],hi[4];
    #pragma unroll
    for(int ks=0;ks<4;++ks){
      asm volatile("ds_read_b64_tr_b16 %0,%1 offset:%c2":"=&v"(lo[ks]):"v"(vb),"i"(d0*4096+ks*1024):"memory");
      asm volatile("ds_read_b64_tr_b16 %0,%1 offset:%c2":"=&v"(hi[ks]):"v"(vb),"i"(d0*4096+ks*1024+512):"memory");}
    asm volatile("s_waitcnt lgkmcnt(0)":::"memory");SBAR();
    #define PK(k) (bf16x8){lo[k][0],lo[k][1],lo[k][2],lo[k][3],hi[k][0],hi[k][1],hi[k][2],hi[k][3]}
    o[d0]=__builtin_amdgcn_mfma_f32_32x32x16_bf16(pa0,PK(0),o[d0],0,0,0);
    o[d0]=__builtin_amdgcn_mfma_f32_32x32x16_bf16(pa1,PK(1),o[d0],0,0,0);
    o[d0]=__builtin_amdgcn_mfma_f32_32x32x16_bf16(pa2,PK(2),o[d0],0,0,0);
    o[d0]=__builtin_amdgcn_mfma_f32_32x32x16_bf16(pa3,PK(3),o[d0],0,0,0);
    #undef PK
  }
}


template<int THRL,bool NOMAX> __device__ __forceinline__ void attn_unit(const bf16*Qw0,int qpitch,const bf16*__restrict__ Kh,const bf16*__restrict__ Vh,int kvpitch,int NT,bf16*Ow0,int opitch,const bf16*Gw0,int gpitch,char*shm,int wave0,const bf16*nKh,const bf16*nVh,bool pre_issued,const bf16*nQw0,const bf16x8 qi0,const bf16x8 qi1,const bf16x8 qi2,const bf16x8 qi3,bf16x8&qn0,bf16x8&qn1,bf16x8&qn2,bf16x8&qn3){
  const int lane=fresh_lane(),r32=lane&31,hi=lane>>5,wid=wave0,tid=wid*64+lane;
  const bf16*Qw=Qw0+(long)(wid*QBLK)*qpitch;
  const unsigned lds0=(unsigned)(uintptr_t)shm;
  float*wsf=(float*)(shm+LDS_WS)+wid*64;
  const bf16*ksrc=Kh+(long)lane*kvpitch+wid*8;
  const bf16*vsrc=Vh+(long)(16*(wid&3)+(lane>>2))*kvpitch+(wid>>2)*32+(lane&3)*8;
  const unsigned kdst=lds0+LDS_K+wid*1024, vdst=lds0+LDS_V+wid*1024;
  #define DMA_K(t,slot) glds16(ksrc+(long)(t)*KVBLK*kvpitch,(unsigned)__builtin_amdgcn_readfirstlane(kdst+(slot)))
  #define DMA_V(t,slot) glds16(vsrc+(long)(t)*KVBLK*kvpitch,(unsigned)__builtin_amdgcn_readfirstlane(vdst+(slot)))
  const int vb0=(int)(lds0+LDS_V)+((lane>>4)&1)*32+(lane&3)*8+(4*hi+((lane&15)>>2))*64;
  const char*Kbase=shm+LDS_K; bf16x8 kf[8];
  const lds_cptr shm3=(lds_cptr)shm; const lds_cptr kp0=shm3+LDS_K+hi*1024+r32*16; const lds_cptr vp0=shm3+LDS_V+((lane>>4)&1)*32+(lane&3)*8+(4*hi+((lane&15)>>2))*64;
  if(!pre_issued){DMA_K(0,0);DMA_V(0,0);DMA_K(1,SLOTB);}
  bf16x8 qr[4];
  if(pre_issued){qr[0]=qi0;qr[1]=qi1;qr[2]=qi2;qr[3]=qi3;}
  else{
    #pragma unroll
    for(int d0=0;d0<4;++d0)qr[d0]=*reinterpret_cast<const bf16x8*>(&Qw[(long)r32*qpitch+d0*16+hi*8]);}
  float mhat=0.f,l_reg=0.f;f32x16 o[2];o[0]=f32x16{};o[1]=f32x16{};f32x16 negm=f32x16{};asm volatile("":"+v"(negm));
  #define CMASK(P0,P1,t) do{}while(0)
  bool resc=false;
  #define START(P0,P1) do{ resc=false; \
    if(!NOMAX){ const float rm=rowmax(P0,P1); const float dl=rm; mhat=fadd_s(mhat,dl); \
      _Pragma("unroll") for(int r=0;r<16;++r){P0[r]=fsub_s(P0[r],dl);P1[r]=fsub_s(P1[r],dl);} \
      _Pragma("unroll") for(int r=0;r<16;++r)negm[r]=-mhat; asm volatile("":"+v"(negm)); } \
    _Pragma("unroll") for(int r=0;r<16;++r)P0[r]=__builtin_amdgcn_exp2f(P0[r]); }while(0)
  #define RESC() do{ if(resc){ asm volatile("s_waitcnt lgkmcnt(0)":::"memory"); \
      _Pragma("unroll") for(int d_=0;d_<2;++d_) _Pragma("unroll") for(int r=0;r<16;++r)o[d_][r]*=wsf[crow(r,hi)]; } }while(0)
  f32x16 pA0,pA1,pB0,pB1;
  int sl_prev=0,sl_cur=0,sl_next=SLOTB;
  #define ROT() do{sl_prev=sl_cur;sl_cur=sl_next;sl_next=(sl_next==(NSLOT-1)*SLOTB)?0:sl_next+SLOTB;}while(0)
  if(!pre_issued){DMA_K(2,2*SLOTB);}
  WAIT_BAR(3);
  qkt(pA0,pA1,Kbase,qr,negm,r32,hi);asm volatile("s_nop 15\n\ts_nop 7":"+v"(pA0),"+v"(pA1));CMASK(pA0,pA1,0);
  START(pA0,pA1);
  _Pragma("unroll") for(int r=0;r<16;++r)pA1[r]=__builtin_amdgcn_exp2f(pA1[r]);
  WAIT_BAR(0);
  DMA_K(3,0);DMA_V(1,SLOTB);
  ROT();
  kload8(kf,kp0+sl_cur);
  WAIT_BAR(2);
  s16x4 vlo[8],vhi[8]; u32x4 pw0,pw1,pw2,pw3;
  #define PKW(P,B) cvtpk_s(P[B],P[B+1])
  #define PAF(k) __builtin_bit_cast(bf16x8,pw##k)
  #define VFR(i) (bf16x8){vlo[i][0],vlo[i][1],vlo[i][2],vlo[i][3],vhi[i][0],vhi[i][1],vhi[i][2],vhi[i][3]}
  #define PIN(x) asm volatile("":"+v"(x))
  #define MX3(a,b,c) __builtin_fmaxf(__builtin_fmaxf((a),(b)),(c))
  #define GAPA(MF,A0,A1,A2,A3,W0,W1,PW) do{ MF; sacc+=A0; sacc+=A1; sacc+=A2; sacc+=A3; PIN(sacc); W0; W1; PIN(PW); SBAR(); }while(0)
  #define EX(v) __builtin_amdgcn_exp2f(v)
  #define GAPB(MF,X,B) do{ MF; X[B]=EX(X[B]); X[B+1]=EX(X[B+1]); X[B+2]=EX(X[B+2]); X[B+3]=EX(X[B+3]); PIN(X); SBAR(); }while(0)
  #define VRD(i) do{ vlo[i]=vtr(vp_+(((i)>>2)*4096+((i)&3)*1024)); vhi[i]=vtr(vp_+(((i)>>2)*4096+((i)&3)*1024+512)); }while(0)
  #define KRD(G,j) do{ if(G){ kload2(kf,kp0+sl_next,j); SBAR(); } }while(0)
  #define STEP(C0,C1,P0,P1,t,GK,GV,GL) do{ SBAR(); \
    const lds_cptr vp_=vp0+sl_prev; \
    VRD(0); SBAR(); float sacc=(P0[0]+P0[1]); \
    GAPA(C0=__builtin_amdgcn_mfma_f32_32x32x16_bf16(kf[0],qr[0],negm,0,0,0), P0[2],P0[3],P0[4],P0[5],     pw0[0]=PKW(P0,0), pw0[1]=PKW(P0,2), pw0); \
    VRD(4); SBAR(); GAPA(C1=__builtin_amdgcn_mfma_f32_32x32x16_bf16(kf[1],qr[0],negm,0,0,0), P0[6],P0[7],P0[8],P0[9],     pw0[2]=PKW(P0,4), pw0[3]=PKW(P0,6), pw0); \
    VRD(1); SBAR(); GAPA(C0=__builtin_amdgcn_mfma_f32_32x32x16_bf16(kf[2],qr[1],C0,0,0,0),   P0[10],P0[11],P0[12],P0[13], pw1[0]=PKW(P0,8), pw1[1]=PKW(P0,10), pw1); \
    VRD(5); SBAR(); GAPA(C1=__builtin_amdgcn_mfma_f32_32x32x16_bf16(kf[3],qr[1],C1,0,0,0),   P0[14],P0[15],P1[0],P1[1],   pw1[2]=PKW(P0,12),pw1[3]=PKW(P0,14), pw1); \
    VRD(2); SBAR(); GAPA(C0=__builtin_amdgcn_mfma_f32_32x32x16_bf16(kf[4],qr[2],C0,0,0,0),   P1[2],P1[3],P1[4],P1[5],     pw2[0]=PKW(P1,0), pw2[1]=PKW(P1,2), pw2); \
    VRD(6); SBAR(); GAPA(C1=__builtin_amdgcn_mfma_f32_32x32x16_bf16(kf[5],qr[2],C1,0,0,0),   P1[6],P1[7],P1[8],P1[9],     pw2[2]=PKW(P1,4), pw2[3]=PKW(P1,6), pw2); \
    VRD(3); SBAR(); GAPA(C0=__builtin_amdgcn_mfma_f32_32x32x16_bf16(kf[6],qr[3],C0,0,0,0),   P1[10],P1[11],P1[12],P1[13], pw3[0]=PKW(P1,8), pw3[1]=PKW(P1,10), pw3); \
    VRD(7); SBAR(); GAPA(C1=__builtin_amdgcn_mfma_f32_32x32x16_bf16(kf[7],qr[3],C1,0,0,0),   P1[14],P1[15],0.f,0.f,       pw3[2]=PKW(P1,12),pw3[3]=PKW(P1,14), pw3); \
    l_reg+=sacc; \
    if(GK){DMA_K((t)+3,sl_cur);} if(GV){DMA_V((t)+1,sl_next);} \
    CMASK(C0,C1,t); \
    if(NOMAX){ resc=false; } else { float a=MX3(C0[0],C0[1],C1[0]),b=MX3(C0[2],C0[3],C1[1]); a=MX3(a,C1[2],C1[3]); \
      _Pragma("unroll") for(int r=4;r<16;r+=4){a=MX3(a,C0[r],C0[r+1]);b=MX3(b,C0[r+2],C0[r+3]);a=MX3(a,C1[r],C1[r+1]);b=MX3(b,C1[r+2],C1[r+3]);} \
      float rm=__builtin_fmaxf(a,b); { auto rr=__builtin_amdgcn_permlane32_swap(__float_as_uint(rm),__float_as_uint(rm),false,false); rm=__builtin_fmaxf(__uint_as_float(rr[0]),__uint_as_float(rr[1])); } \
      resc=false; \
      if(__builtin_expect(__any(rm>(float)THRL),0)){ const float dl=__builtin_fmaxf(rm,0.f); mhat+=dl; \
        _Pragma("unroll") for(int r=0;r<16;++r){C0[r]-=dl;C1[r]-=dl;} \
        _Pragma("unroll") for(int r=0;r<16;++r)negm[r]=-mhat; asm volatile("":"+v"(negm)); \
        const float f=__builtin_amdgcn_exp2f(-dl); l_reg*=f; if(hi==0)wsf[r32]=f; resc=true; } } \
    SBAR(); \
    GAPB(o[0]=__builtin_amdgcn_mfma_f32_32x32x16_bf16(PAF(0),VFR(0),o[0],0,0,0), C0,0); \
    GAPB(o[1]=__builtin_amdgcn_mfma_f32_32x32x16_bf16(PAF(0),VFR(4),o[1],0,0,0), C0,4); \
    KRD(GL,0); GAPB(o[0]=__builtin_amdgcn_mfma_f32_32x32x16_bf16(PAF(1),VFR(1),o[0],0,0,0), C0,8); \
    KRD(GL,1); GAPB(o[1]=__builtin_amdgcn_mfma_f32_32x32x16_bf16(PAF(1),VFR(5),o[1],0,0,0), C0,12); \
    KRD(GL,2); GAPB(o[0]=__builtin_amdgcn_mfma_f32_32x32x16_bf16(PAF(2),VFR(2),o[0],0,0,0), C1,0); \
    KRD(GL,3); GAPB(o[1]=__builtin_amdgcn_mfma_f32_32x32x16_bf16(PAF(2),VFR(6),o[1],0,0,0), C1,4); \
    GAPB(o[0]=__builtin_amdgcn_mfma_f32_32x32x16_bf16(PAF(3),VFR(3),o[0],0,0,0), C1,8); \
    GAPB(o[1]=__builtin_amdgcn_mfma_f32_32x32x16_bf16(PAF(3),VFR(7),o[1],0,0,0), C1,12); \
    }while(0)
  int t=1;
  #undef CMASK
  #define CMASK(P0,P1,t) do{}while(0)
  for(;t+5<NT;t+=2){
    STEP(pB0,pB1,pA0,pA1,t,true,true,true);     WAIT_BAR(2); RESC(); ROT();
    STEP(pA0,pA1,pB0,pB1,t+1,true,true,true);   WAIT_BAR(2); RESC(); ROT();
  }
  #undef CMASK
  #define CMASK(P0,P1,t) do{}while(0)
  #define ENDW(tt) do{ if((tt)+3<NT){WAIT_BAR(2);} else if((tt)+2<NT){WAIT_BAR(1);} else {WAIT_BAR(0);} }while(0)
  for(;t+1<NT;t+=2){
    STEP(pB0,pB1,pA0,pA1,t,(t+3<NT),(t+1<NT),(t+1<NT));       ENDW(t);   RESC(); ROT();
    STEP(pA0,pA1,pB0,pB1,t+1,(t+4<NT),(t+2<NT),(t+2<NT));     ENDW(t+1); RESC(); ROT();
  }
  if(nKh){
    const bf16*nks=nKh+(long)lane*kvpitch+wid*8; const bf16*nvs=nVh+(long)(16*(wid&3)+(lane>>2))*kvpitch+(wid>>2)*32+(lane&3)*8;
    glds16(nks,(unsigned)__builtin_amdgcn_readfirstlane(kdst)); glds16(nvs,(unsigned)__builtin_amdgcn_readfirstlane(vdst));
    glds16(nks+(long)KVBLK*kvpitch,(unsigned)__builtin_amdgcn_readfirstlane(kdst+SLOTB)); glds16(nks+(long)2*KVBLK*kvpitch,(unsigned)__builtin_amdgcn_readfirstlane(kdst+2*SLOTB)); }
  STEP(pB0,pB1,pA0,pA1,NT-1,false,false,false); RESC();
  { float sacc=pB0[0]+pB0[1]; _Pragma("unroll") for(int r=2;r<16;++r)sacc+=pB0[r]; _Pragma("unroll") for(int r=0;r<16;++r)sacc+=pB1[r]; l_reg+=sacc;
    pw0=(u32x4){PKW(pB0,0),PKW(pB0,2),PKW(pB0,4),PKW(pB0,6)};pw1=(u32x4){PKW(pB0,8),PKW(pB0,10),PKW(pB0,12),PKW(pB0,14)};pw2=(u32x4){PKW(pB1,0),PKW(pB1,2),PKW(pB1,4),PKW(pB1,6)};pw3=(u32x4){PKW(pB1,8),PKW(pB1,10),PKW(pB1,12),PKW(pB1,14)};
    SBAR(); pv(o,vb0+sl_cur,PAF(0),PAF(1),PAF(2),PAF(3)); }
  if(nKh){ const bf16*nQw=nQw0+(long)(wid*QBLK)*qpitch;
    qn0=*reinterpret_cast<const bf16x8*>(&nQw[(long)r32*qpitch+hi*8]); qn1=*reinterpret_cast<const bf16x8*>(&nQw[(long)r32*qpitch+16+hi*8]); qn2=*reinterpret_cast<const bf16x8*>(&nQw[(long)r32*qpitch+32+hi*8]); qn3=*reinterpret_cast<const bf16x8*>(&nQw[(long)r32*qpitch+48+hi*8]); }
  #undef PKW
  #undef PAF
  #undef VFR
  #undef PIN
  #undef MX3
  #undef GAPA
  #undef GAPB
  #undef EX
  #undef VRD
  #undef KRD
  #undef STEP
  #undef ENDW
  {auto rr=__builtin_amdgcn_permlane32_swap(__float_as_uint(l_reg),__float_as_uint(l_reg),false,false);l_reg=__uint_as_float(rr[0])+__uint_as_float(rr[1]);}
  if(hi==0)wsf[32+r32]=l_reg;asm volatile("s_waitcnt lgkmcnt(0)":::"memory");
  float rli[16];
  #pragma unroll
  for(int r=0;r<16;++r)rli[r]=__builtin_amdgcn_rcpf(wsf[32+crow(r,hi)]);
  bf16*Ow=Ow0+(long)(wid*QBLK)*opitch; const bf16*Gw=Gw0+(long)(wid*QBLK)*gpitch;
  { bf16*stg=(bf16*)(shm+LDS_OST)+wid*2048;
    u32x4 gv[4];
    #pragma unroll
    for(int i=0;i<4;++i){const int row=i*8+(lane>>3),ch=lane&7; gv[i]=*(const u32x4*)(Gw+(long)row*gpitch+ch*8);}
    #pragma unroll
    for(int r=0;r<16;++r){const int orow=crow(r,hi);
      #pragma unroll
      for(int d0=0;d0<2;++d0)stg[orow*64+d0*32+r32]=__float2bfloat16(o[d0][r]*rli[r]);}
    asm volatile("s_waitcnt lgkmcnt(0)":::"memory");
    #pragma unroll
    for(int i=0;i<4;++i){const int row=i*8+(lane>>3),ch=lane&7; const u32x4 v=*(const u32x4*)(stg+row*64+ch*8); u32x4 w;
      #pragma unroll
      for(int q=0;q<4;++q){ const float a0=__uint_as_float(v[q]<<16),a1=__uint_as_float(v[q]&0xffff0000u),g0=__uint_as_float(gv[i][q]<<16),g1=__uint_as_float(gv[i][q]&0xffff0000u);
        const float s0=g0*__builtin_amdgcn_rcpf(1.0f+__builtin_amdgcn_exp2f(-1.4426950408889634f*g0)),s1=g1*__builtin_amdgcn_rcpf(1.0f+__builtin_amdgcn_exp2f(-1.4426950408889634f*g1)); w[q]=cvtpk_s(a0*s0,a1*s1); }
      ATTN_STORE16(Ow+(long)row*opitch+ch*8,w);} }
  asm volatile("s_waitcnt lgkmcnt(0)\n\ts_barrier":::"memory");
  #undef DMA_K
  #undef DMA_V
  #undef CMASK
  #undef START
  #undef RESC
  #undef ROT
}
constexpr int ATTN_LDS_BYTES=LDS_BYTES;
#undef SBAR
#undef WAIT_BAR
}
#define GAS __attribute__((address_space(1)))
#define LAS __attribute__((address_space(3)))
#define XB_TMO      128
#define XB_XCNT(j)  (256  + 64 * (j))
#define XB_XSUB(j)  (1280 + 64 * (j))
#define XB_XGEN(j)  (2304 + 64 * (j))
#define XB_TOP      3328
#define XB_TOPGEN   3392
#define XCD_BAR_WORDS 3456
#define XB_SPIN_CAP (1u << 18)

__device__ __forceinline__ unsigned xb_ld(unsigned* p)              { return __hip_atomic_load(p, __ATOMIC_RELAXED, __HIP_MEMORY_SCOPE_AGENT); }
__device__ __forceinline__ unsigned xb_add(unsigned* p, unsigned v) { return __hip_atomic_fetch_add(p, v, __ATOMIC_RELAXED, __HIP_MEMORY_SCOPE_AGENT); }
__device__ __forceinline__ unsigned xb_xcc_id() { return (unsigned)__builtin_amdgcn_s_getreg((3 << 11) | 20) & 0xFu; }
#define XB_SPIN(cond, bar) do { unsigned _sp = 0; while (cond) { __builtin_amdgcn_s_sleep(1); \
    if ((++_sp & 255u) == 0u) { if (xb_ld(&(bar)[XB_TMO])) break; if (_sp > XB_SPIN_CAP) { atomicAdd(&(bar)[XB_TMO], 1u); break; } } } } while (0)

struct XcdBarrier {
    unsigned* bar; unsigned x;
    volatile LAS unsigned* st;
    int wave;
};

__device__ __forceinline__ XcdBarrier xcd_barrier_post(unsigned* bar, volatile LAS unsigned* st, int wave) {
    XcdBarrier b; b.bar = bar; b.x = xb_xcc_id(); b.st = st; b.wave = wave;
    if (wave == 0 && fresh_lane() == 0) (void)xb_add(&bar[XB_XCNT(b.x)], 1u);
    return b;
}
__device__ __forceinline__ void xcd_barrier_complete(unsigned* bar, unsigned x, unsigned& nloc, unsigned& nx) {
    const unsigned G = gridDim.x * gridDim.y * gridDim.z;
    unsigned sum, cnt, mine, sp = 0u;
    for (;;) {
        sum = 0u; cnt = 0u; mine = 0u;
#pragma unroll
        for (unsigned j = 0; j < 16; ++j) { const unsigned c = xb_ld(&bar[XB_XCNT(j)]); sum += c; cnt += (c > 0u) ? 1u : 0u; mine = (j == x) ? c : mine; }
        if (sum == G) break;
        __builtin_amdgcn_s_sleep(1);
        if ((++sp & 255u) == 0u) { if (xb_ld(&bar[XB_TMO])) break; if (sp > XB_SPIN_CAP) { atomicAdd(&bar[XB_TMO], 1u); break; } }
    }
    nloc = mine > 0u ? mine : 1u; nx = cnt > 0u ? cnt : 1u;
}

__device__ __forceinline__ void xcd_barrier(const XcdBarrier& b) {
    asm volatile("s_waitcnt vmcnt(0)" ::: "memory");
    __syncthreads();
    if (b.wave == 0 && fresh_lane() == 0) {
        unsigned* bar = b.bar;
        __builtin_amdgcn_s_waitcnt(0);
        unsigned nloc = b.st[0], nx = b.st[1];
        if (nloc == 0u) { xcd_barrier_complete(bar, b.x, nloc, nx); b.st[0] = nloc; b.st[1] = nx; }
        const unsigned old = xb_add(&bar[XB_XSUB(b.x)], 1u);
        const unsigned gen = old / nloc;
        if (old + 1u == (gen + 1u) * nloc) {
            __builtin_amdgcn_fence(__ATOMIC_RELEASE, "agent");
            asm volatile("s_waitcnt vmcnt(0)" ::: "memory");
            const unsigned og = xb_add(&bar[XB_TOP], 1u);
            const unsigned tg = og / nx;
            if (og + 1u == (tg + 1u) * nx) xb_add(&bar[XB_TOPGEN], 1u);
            else XB_SPIN(xb_ld(&bar[XB_TOPGEN]) == tg, bar);
            __builtin_amdgcn_fence(__ATOMIC_ACQUIRE, "agent");
            xb_add(&bar[XB_XGEN(b.x)], 1u);
            asm volatile("s_waitcnt vmcnt(0)" ::: "memory");
        } else {
            XB_SPIN(xb_ld(&bar[XB_XGEN(b.x)]) == gen, bar);
            __builtin_amdgcn_fence(__ATOMIC_ACQUIRE, "agent");
            asm volatile("s_waitcnt vmcnt(0)" ::: "memory");
        }
    }
    __syncthreads();
}
typedef unsigned short bf16;
typedef unsigned v4u __attribute__((ext_vector_type(4)));
typedef unsigned v2u __attribute__((ext_vector_type(2)));
typedef float f32x4 __attribute__((ext_vector_type(4)));
typedef float f32x16 __attribute__((ext_vector_type(16)));
typedef short bf16x8 __attribute__((ext_vector_type(8)));
constexpr int NWAVES = 8;
constexpr int NB = 32, LSEQ = 2048, LCTX = 256, DM = 1024, NIN = 2816;
constexpr int ROWS_X = NB * LSEQ, ROWS_C = NB * LCTX, MT = ROWS_X + ROWS_C;
constexpr float LN_EPS = 1e-6f;
constexpr size_t MiB = 1u << 20;
constexpr size_t WS_CTL = 0;
constexpr size_t WS_WIN = 1 * MiB;
constexpr size_t WS_WOUT = 12 * MiB;
constexpr size_t WS_PWT = 16 * MiB;
constexpr size_t WS_ROPE = WS_PWT + 65536;
constexpr size_t WS_MOD = WS_PWT + 131072;
constexpr size_t WS_MODP = 17 * MiB;
constexpr size_t WS_HF = 31 * MiB;
constexpr size_t WS_HX = 40 * MiB;
constexpr size_t WS_PX = 184 * MiB;
constexpr size_t WS_KALL = 580 * MiB;
constexpr size_t WS_VALL = 598 * MiB;
constexpr size_t WS_HYT = 616 * MiB;
constexpr size_t WS_HYTC = 680 * MiB;
constexpr size_t WS_YHT = 688 * MiB;
constexpr size_t WS_YHTC = 720 * MiB;
constexpr size_t WS_GY = WS_PX;
constexpr size_t WS_GY0 = 724 * MiB;
constexpr size_t WS_END = 868 * MiB;
constexpr int LDS_BYTES = 163840;
constexpr int STG_OFF = 131072;
constexpr int MISC_OFF = LDS_BYTES - 64;

__device__ __forceinline__ unsigned f2bf(float f) { unsigned u = __builtin_bit_cast(unsigned, f); return (u + 0x7fffu + ((u >> 16) & 1u)) >> 16; }
typedef float f32x2_t __attribute__((ext_vector_type(2))); typedef __bf16 bf16x2_t __attribute__((ext_vector_type(2)));
__device__ __forceinline__ unsigned pk2(float lo, float hi) { f32x2_t v = {lo, hi}; bf16x2_t b = __builtin_convertvector(v, bf16x2_t); return __builtin_bit_cast(unsigned, b); }
__device__ __forceinline__ float bflo(unsigned w) { return __uint_as_float(w << 16); }
__device__ __forceinline__ float bfhi(unsigned w) { return __uint_as_float(w & 0xffff0000u); }
__device__ __forceinline__ float bf1(unsigned short h) { return __uint_as_float(((unsigned)h) << 16); }
__device__ __forceinline__ float rdlane(float v, int l) { return __int_as_float(__builtin_amdgcn_readlane(__float_as_int(v), l)); }
__device__ __forceinline__ float silu(float x) { return x / (1.0f + __expf(-x)); }
__device__ __forceinline__ float silu_fast(float x) { return x * __builtin_amdgcn_rcpf(1.0f + __builtin_amdgcn_exp2f(-1.4426950408889634f * x)); }

struct Frame {
    LAS unsigned char* lds;
    int tid, lane, wave, vcu, G;
    const float* const* in;
    float* out; unsigned char* ws;
};

__device__ __forceinline__ void p0_transpose_item(const float* W, int N, bf16* WT, bool permuted, LAS float* scr, int item, int lane) {
    const int nblk = N / 32, kb = item / nblk, nbp = item % nblk, k0 = 64 * kb, pb = 32 * nbp;
    int lcol = pb + (lane & 31);
    if (permuted) { const int tile = pb >> 8, pc = pb & 255, bj = pc >> 7, wc = (pc >> 5) & 3, q = lane & 31, n = q >> 4, fq = (q >> 2) & 3, e = q & 3;
        if (tile >= 6 && tile <= 8) lcol = tile * 256 + 64 * wc + 32 * (fq >> 1) + 16 * bj + 8 * (fq & 1) + 4 * n + e;
        else lcol = tile * 256 + 128 * bj + 32 * wc + 8 * fq + 4 * n + e; }
#pragma unroll 8
    for (int i = 0; i < 32; ++i) { const int kk = 2 * i + (lane >> 5); scr[kk * 33 + (lane & 31)] = W[(size_t)(k0 + kk) * N + lcol]; }
    asm volatile("s_waitcnt lgkmcnt(0)" ::: "memory");
    const int c = lane & 7;
#pragma unroll
    for (int j = 0; j < 4; ++j) { const int q = (lane >> 3) + 8 * j;
        const LAS float* s = scr + (8 * c) * 33 + q;
        v4u o; o.x = pk2(s[0 * 33], s[1 * 33]); o.y = pk2(s[2 * 33], s[3 * 33]); o.z = pk2(s[4 * 33], s[5 * 33]); o.w = pk2(s[6 * 33], s[7 * 33]);
        *(v4u*)(WT + (size_t)(pb + q) * 1024 + k0 + 8 * c) = o; }
    asm volatile("s_waitcnt lgkmcnt(0)" ::: "memory");
}
constexpr int MOD_KC = 16;
__device__ __forceinline__ void p0_mod_task(const Frame& F, int task, LAS float* scr) {
    const int layer = task / (48 * MOD_KC), rem = task % (48 * MOD_KC), cgp = rem / MOD_KC, kc = rem % MOD_KC, lane = F.lane;
    const int k0 = 64 * kc;
    const float* W = F.in[4] + (size_t)layer * 1024 * 3072 + (size_t)k0 * 3072 + 64 * cgp + lane;
    const float* c = F.in[1]; const float* cc = F.in[3];
#pragma unroll
    for (int kk = 0; kk < 64; kk += 16) { float t[16];
#pragma unroll
        for (int j = 0; j < 16; ++j) t[j] = W[(size_t)(kk + j) * 3072];
#pragma unroll
        for (int j = 0; j < 16; ++j) scr[(kk + j) * 64 + lane] = t[j]; }
    float sv[33], acc[33];
#pragma unroll
    for (int b = 0; b < 32; ++b) sv[b] = c[b * 1024 + k0 + lane];
    sv[32] = cc[k0 + lane];
#pragma unroll
    for (int b = 0; b < 33; ++b) { sv[b] = silu(sv[b]); acc[b] = 0.f; }
    asm volatile("s_waitcnt lgkmcnt(0)" ::: "memory");
#pragma unroll 2
    for (int kk = 0; kk < 64; ++kk) { const float w = scr[kk * 64 + lane];
#pragma unroll
        for (int b = 0; b < 33; ++b) acc[b] = fmaf(rdlane(sv[b], kk), w, acc[b]); }
    float* P = (float*)(F.ws + WS_MODP) + ((size_t)(layer * MOD_KC + kc) * 33) * 3072 + 64 * cgp + lane;
#pragma unroll
    for (int b = 0; b < 33; ++b) P[(size_t)b * 3072] = acc[b];
    asm volatile("s_waitcnt lgkmcnt(0)" ::: "memory");
}
constexpr int FW1 = 0, FW2 = 33 * 64 * 4, FW3 = FW2 + 64 * 64 * 4, FW_END = FW3 + 64 * 512 * 4;
__device__ __forceinline__ void p0_filter_task(const Frame& F, int fidx, int t) {
    const int L = fidx == 2 ? 256 : 2048, layer = fidx == 1 ? 1 : 0, lane = F.lane;
    const LAS float* w1 = (const LAS float*)(F.lds + FW1); const float* b1 = F.in[12] + layer * 64; const float* fq = F.in[13] + layer * 128;
    const LAS float* w2 = (const LAS float*)(F.lds + FW2); const float* b2 = F.in[15] + layer * 64; const LAS float* w3 = (const LAS float*)(F.lds + FW3);
    const float tl = (float)t / (float)(L - 1);
    float z = 0.f;
    if (lane == 0) z = tl;
    else if (lane < 33) { const int j = (lane - 1) & 15; const double frj = 1e-4 + (double)j * ((15.0 - 1e-4) / 15.0);
        double ph = frj * (double)t / (double)L; ph -= floor(ph);
        const float a = (float)(2.0 * ph);
        z = lane < 17 ? cospif(a) : -sinpif(a); }
    float h1 = b1[lane];
    for (int j = 0; j < 33; ++j) h1 = fmaf(rdlane(z, j), w1[j * 64 + lane], h1);
    h1 = sinf(fq[lane] * h1);
    float h2 = b2[lane];
#pragma unroll 8
    for (int m = 0; m < 64; ++m) h2 = fmaf(rdlane(h1, m), w2[m * 64 + lane], h2);
    h2 = sinf(fq[64 + lane] * h2);
    float o[8];
#pragma unroll
    for (int q = 0; q < 8; ++q) o[q] = 0.f;
#pragma unroll 4
    for (int m = 0; m < 64; ++m) { const float hm = rdlane(h2, m);
#pragma unroll
        for (int q = 0; q < 8; ++q) o[q] = fmaf(hm, w3[m * 512 + 64 * q + lane], o[q]); }
    float* HF = (float*)(F.ws + WS_HF) + (fidx == 0 ? 0 : fidx == 1 ? (size_t)512 * 2048 : (size_t)2 * 512 * 2048);
    const float dmin = 3.0701134573253943f, dmax = 15.350567286626972f;
#pragma unroll
    for (int q = 0; q < 8; ++q) { const int cp = 64 * q + lane, ch = cp & 255; const float dl = dmin + (float)ch * ((dmax - dmin) / 255.0f);
        HF[(size_t)cp * L + t] = o[q] * __expf(-tl * dl); }
}
__device__ __forceinline__ void p0a_phase(const Frame& F) {
    const int lane = F.lane;
    { const int half = F.G / 2, wl = F.vcu >= half ? 1 : 0;
      LAS float* L1 = (LAS float*)(F.lds + FW1); LAS float* L2 = (LAS float*)(F.lds + FW2); LAS float* L3 = (LAS float*)(F.lds + FW3);
      const float* g1 = F.in[11] + wl * 33 * 64; const float* g2 = F.in[14] + wl * 64 * 64; const float* g3 = F.in[16] + wl * 64 * 512;
      for (int i = F.tid; i < 33 * 64; i += 512) L1[i] = g1[i];
      for (int i = F.tid; i < 64 * 64; i += 512) L2[i] = g2[i];
      for (int i = F.tid; i < 64 * 512 / 4; i += 512) ((LAS f32x4*)L3)[i] = ((const f32x4*)g3)[i];
      __syncthreads();
      const int nw = half * NWAVES, w0 = (F.vcu - wl * half) * NWAVES + F.wave, ntask = wl ? 2048 : 2304;
      for (int it = w0; it < ntask; it += nw) { if (wl) p0_filter_task(F, 1, it); else if (it < 2048) p0_filter_task(F, 0, it); else p0_filter_task(F, 2, it - 2048); }
      __syncthreads(); }
    LAS float* scr = (LAS float*)(F.lds + F.wave * 16384);
    const int gw = F.vcu * NWAVES + F.wave, NGW = F.G * NWAVES;
    constexpr int T_MOD = 2 * 48 * MOD_KC, T_WIN = 2 * 16 * 88, T_WOUT = 2 * 16 * 32, T_PW = 512, T_ROPE = 16;
    constexpr int NT = T_MOD + T_WIN + T_WOUT + T_PW + T_ROPE;
    for (int it = gw; it < NT; it += NGW) {
        int r = it;
        if (r < T_MOD) { p0_mod_task(F, r, scr); continue; } r -= T_MOD;
        if (r < T_WIN) { const int layer = r / (16 * 88); p0_transpose_item(F.in[6] + (size_t)layer * 1024 * NIN, NIN, (bf16*)(F.ws + WS_WIN) + (size_t)layer * NIN * 1024, true, scr, r % (16 * 88), lane); continue; } r -= T_WIN;
        if (r < T_WOUT) { const int layer = r / (16 * 32); p0_transpose_item(F.in[20] + (size_t)layer * 1024 * 1024, 1024, (bf16*)(F.ws + WS_WOUT) + (size_t)layer * 1024 * 1024, false, scr, r % (16 * 32), lane); continue; } r -= T_WOUT;
        if (r < T_PW) { const int lg = r >> 6, dout = r & 63;
            ((bf16*)(F.ws + WS_PWT))[(size_t)(lg * 64 + dout) * 64 + lane] = (bf16)f2bf(F.in[7][(size_t)(lg * 64 + lane) * 64 + dout]); continue; } r -= T_PW;
        { const int idx = r * 64 + lane, p = idx >> 4, i = idx & 15; const float inv = exp2f(-(float)i * (13.287712379549449f / 16.0f)); const float ang = (float)p * inv;
            float* R = (float*)(F.ws + WS_ROPE); R[2 * idx] = cosf(ang); R[2 * idx + 1] = sinf(ang); }
    }
}
__device__ __forceinline__ void ln_stats(const f32x4 (&v)[4], float& mean, float& rstd) {
    float s = 0.f;
#pragma unroll
    for (int j = 0; j < 4; ++j) s += (v[j][0] + v[j][1]) + (v[j][2] + v[j][3]);
    mean = wave_sum(s) * (1.f / DM); float s2 = 0.f;
#pragma unroll
    for (int j = 0; j < 4; ++j) { const f32x4 d = v[j] - mean; s2 += (d[0] * d[0] + d[1] * d[1]) + (d[2] * d[2] + d[3] * d[3]); }
    rstd = 1.f / sqrtf(wave_sum(s2) * (1.f / DM) + LN_EPS);
}
__device__ __forceinline__ void ln_phase(const Frame& F, int mode) {
    const int gw = F.vcu * NWAVES + F.wave, NGW = F.G * NWAVES, lane = F.lane;
    const int nrows = mode == 2 ? ROWS_X : MT, per = nrows / NGW, ngrp = per / 2, rbase = gw * per;
    bf16* HX = (bf16*)(F.ws + WS_HX); const bf16* GY = (const bf16*)(F.ws + WS_GY0); const bf16* GY1 = (const bf16*)(F.ws + WS_GY);
    const float* MOD = (const float*)(F.ws + WS_MOD); const float* MODP = (const float*)(F.ws + WS_MODP);
    f32x4 sh[4], sc[4], lg[4], lb[4];
    if (mode >= 1) {
#pragma unroll
        for (int j = 0; j < 4; ++j) { const int col = 4 * lane + 256 * j; lg[j] = *(const f32x4*)(F.in[21] + col); lb[j] = *(const f32x4*)(F.in[22] + col); }
    }
    int cur_b = -1;
    LAS float* MS = (LAS float*)F.lds; const int wg_r0 = F.vcu * NWAVES * per, wg_b0 = wg_r0 >= ROWS_X ? 32 : (wg_r0 >> 11);
    if (mode == 0) { const int rl = wg_r0 + NWAVES * per - 1, wg_b1 = rl >= ROWS_X ? 32 : (rl >> 11); const int t4 = 4 * F.tid;
        for (int sl = 0; sl < 2; ++sl) { const int bb = sl == 0 ? wg_b0 : wg_b1; if (sl == 1 && wg_b1 == wg_b0) break;
            f32x4 a = *(const f32x4*)(F.in[5] + t4);
#pragma unroll
            for (int kc = 0; kc < MOD_KC; ++kc) a += *(const f32x4*)(MODP + ((size_t)kc * 33 + bb) * 3072 + t4);
            *(LAS f32x4*)(MS + sl * 2048 + t4) = a; }
        __syncthreads(); }
    f32x4 v[2][4], nv[2][4]; v2u gq[2][4], ngq[2][4], gq1[2][4], ngq1[2][4];
#define LN_SRC(row) ((row) >= ROWS_X ? F.in[2] + (size_t)((row) - ROWS_X) * DM : F.in[0] + (size_t)(row) * DM)
#define LN_LOAD(V, Q, Q1, r0_) do { _Pragma("unroll") for (int rr = 0; rr < 2; ++rr) { const float* src_ = LN_SRC((r0_) + rr); \
        _Pragma("unroll") for (int j = 0; j < 4; ++j) V[rr][j] = __builtin_nontemporal_load((const f32x4*)src_ + lane + 64 * j); \
        if (mode >= 1) { const v2u* gp_ = (const v2u*)(GY + (size_t)((r0_) + rr) * DM) + lane; _Pragma("unroll") for (int j = 0; j < 4; ++j) Q[rr][j] = __builtin_nontemporal_load(gp_ + 64 * j); } \
        if (mode == 2) { const v2u* gp1_ = (const v2u*)(GY1 + (size_t)((r0_) + rr) * DM) + lane; _Pragma("unroll") for (int j = 0; j < 4; ++j) Q1[rr][j] = __builtin_nontemporal_load(gp1_ + 64 * j); } } } while (0)
    LN_LOAD(v, gq, gq1, rbase);
    for (int g = 0; g < ngrp; ++g) {
        const int r0 = rbase + 2 * g; const bool isctx = r0 >= ROWS_X; const int bidx = isctx ? 32 : (r0 >> 11);
        if (g + 1 < ngrp) LN_LOAD(nv, ngq, ngq1, r0 + 2);
        if (mode <= 1 && bidx != cur_b) { cur_b = bidx;
            if (mode == 0) { const LAS float* ms = MS + (bidx == wg_b0 ? 0 : 2048);
#pragma unroll
                for (int j = 0; j < 4; ++j) { const int col = 4 * lane + 256 * j; sh[j] = *(const LAS f32x4*)(ms + col); sc[j] = *(const LAS f32x4*)(ms + 1024 + col); }
            } else {
#pragma unroll
                for (int j = 0; j < 4; ++j) { const int col = 4 * lane + 256 * j; const float* P = MOD + ((size_t)33 + bidx) * 3072 + col; sh[j] = *(const f32x4*)P; sc[j] = *(const f32x4*)(P + 1024); }
            } }
#pragma unroll
        for (int rr = 0; rr < 2; ++rr) {
            const int row = r0 + rr; float mean, rstd;
            if (mode >= 1) {
#pragma unroll
                for (int j = 0; j < 4; ++j) { const v2u q = gq[rr][j]; v[rr][j] = v[rr][j] * 1.4142135623730951f + (f32x4){bflo(q.x), bfhi(q.x), bflo(q.y), bfhi(q.y)}; }
                ln_stats(v[rr], mean, rstd);
#pragma unroll
                for (int j = 0; j < 4; ++j) v[rr][j] = (v[rr][j] - mean) * rstd * lg[j] + lb[j];
            }
            if (mode == 2) {
#pragma unroll
                for (int j = 0; j < 4; ++j) { const v2u q = gq1[rr][j]; v[rr][j] = v[rr][j] * 1.4142135623730951f + (f32x4){bflo(q.x), bfhi(q.x), bflo(q.y), bfhi(q.y)}; }
                ln_stats(v[rr], mean, rstd);
                float* dstf = F.out + (size_t)row * DM;
#pragma unroll
                for (int j = 0; j < 4; ++j) { const int col = 4 * lane + 256 * j + DM; v[rr][j] = (v[rr][j] - mean) * rstd * *(const f32x4*)(F.in[21] + col) + *(const f32x4*)(F.in[22] + col); }
#if MK_CHECK
                if (((const unsigned*)(F.ws + WS_CTL))[3600] != 0u) { const float q_ = __builtin_nanf(""); _Pragma("unroll") for (int j = 0; j < 4; ++j) v[rr][j] = (f32x4){q_, q_, q_, q_}; }
#endif
#pragma unroll
                for (int j = 0; j < 4; ++j) *((f32x4*)dstf + lane + 64 * j) = v[rr][j];
            }
            if (mode <= 1) {
                ln_stats(v[rr], mean, rstd);
                v2u* o8 = (v2u*)(HX + (size_t)row * DM) + lane;
#pragma unroll
                for (int j = 0; j < 4; ++j) { const f32x4 y = (v[rr][j] - mean) * rstd * (sc[j] + 1.0f) + sh[j]; v2u w; w.x = pk2(y[0], y[1]); w.y = pk2(y[2], y[3]); o8[64 * j] = w; }
            }
        }
#pragma unroll
        for (int rr = 0; rr < 2; ++rr)
#pragma unroll
            for (int j = 0; j < 4; ++j) { v[rr][j] = nv[rr][j]; gq[rr][j] = ngq[rr][j]; gq1[rr][j] = ngq1[rr][j]; }
    }
#undef LN_LOAD
#undef LN_SRC
}
__device__ __forceinline__ void mod_finalize(const Frame& F) {
    float* MOD = (float*)(F.ws + WS_MOD); const float* MODP = (const float*)(F.ws + WS_MODP);
    for (int idx = F.vcu * 512 + F.tid; idx < 2 * 33 * 3072; idx += F.G * 512) {
        const int layer = idx / (33 * 3072), rem = idx % (33 * 3072), bidx = rem / 3072, n = rem % 3072;
        float s = F.in[5][layer * 3072 + n];
        for (int kc = 0; kc < MOD_KC; ++kc) s += MODP[((size_t)(layer * MOD_KC + kc) * 33 + bidx) * 3072 + n];
        MOD[idx] = s;
    }
}

template <int L> struct HyLds { static constexpr int CS = 4 * L + 32, U_OFF = 8 * CS, UP = 528, UBUF = 32 * UP, RED_OFF = U_OFF + 2 * UBUF; };
template <int L> __device__ __forceinline__ void hyena_unit(const Frame& F, int c, const float* hf, const float* hb, const bf16* X1, const bf16* V, const float* cw, const float* cb, float hbias, bf16* Y) {
    typedef HyLds<L> H;
    LAS unsigned char* lds = F.lds; const int lane = fresh_lane(), w = F.wave, tid = w * 64 + lane;
    LAS float* Ef = (LAS float*)(lds + H::U_OFF);
    float s = 0.f;
    { constexpr int NK = (2 * L + 8 + 511) / 512; float fa[NK], fb[NK];
#pragma unroll
      for (int k = 0; k < NK; ++k) { const int n = L - (tid + 512 * k); fa[k] = hf[min(max(n, 0), L - 1)]; fb[k] = hb[min(max(-n, 0), L - 1)]; }
#pragma unroll
      for (int k = 0; k < NK; ++k) { const int i = tid + 512 * k, n = L - i;
        const float mf = (n >= 0 && n < L) ? 1.f : 0.f, mb = (n < 0 && n > -L) ? 1.f : 0.f;
        const float gq = fa[k] * mf + fb[k] * mb;
        if (i < 2 * L + 8) Ef[i] = gq;
        s += fabsf(gq); } }
    s = wave_sum(s);
    LAS float* red = (LAS float*)(lds + H::RED_OFF);
    if (lane == 0) red[w] = s;
    __syncthreads();
    float tot = 0.f;
#pragma unroll
    for (int i = 0; i < 8; ++i) tot += red[i];
    const float inv = 1.0f / tot;
#pragma unroll 8
    for (int idx = tid; idx < 8 * 2 * L; idx += 512) { const int sig = idx / (2 * L), i = idx % (2 * L);
        *(LAS unsigned short*)(lds + sig * H::CS + 2 * i) = (unsigned short)f2bf(Ef[i + sig] * inv); }
    __syncthreads();
    const float xa = cw[256 + c], xb = cw[768 + 256 + c], xc = cw[1536 + 256 + c], xbias = cb[256 + c];
    const float va = cw[512 + c], vb = cw[768 + 512 + c], vc = cw[1536 + 512 + c], vbias = cb[512 + c];
    constexpr int TPW = L / 256, NCH = L / 256;
    const int r = lane & 31, h = lane >> 5, tw0 = w * 32 * TPW;
    const int sig = (8 - (r & 7)) & 7, rc8 = (r + 7) >> 3;
    const int abase = sig * H::CS + 2 * (L - 8 * rc8 + 8 * h - tw0);
    f32x16 acc[TPW];
#pragma unroll
    for (int i = 0; i < TPW; ++i) acc[i] = f32x16{};
    const int pb = tid >> 4, seg = tid & 15;
    const unsigned prow = (unsigned)(pb * L + 16 * seg);
    v4u rx0, rx1, rv0, rv1; unsigned short hxm, hxp, hvm, hvp;
#define HY_LOAD(S0) do { const int s_ = (S0) + 16 * seg; const unsigned o_ = prow + (unsigned)(S0); rx0 = *(const v4u*)(X1 + o_); rx1 = *(const v4u*)(X1 + o_ + 8u); rv0 = *(const v4u*)(V + o_); rv1 = *(const v4u*)(V + o_ + 8u); \
        hxm = s_ > 0 ? X1[o_ - 1u] : (unsigned short)0; hvm = s_ > 0 ? V[o_ - 1u] : (unsigned short)0; hxp = s_ + 16 < L ? X1[o_ + 16u] : (unsigned short)0; hvp = s_ + 16 < L ? V[o_ + 16u] : (unsigned short)0; } while (0)
#define HY_PRODUCE(bufi) do { float xv[18], vv[18]; \
            xv[0] = bf1(hxm); vv[0] = bf1(hvm); xv[17] = bf1(hxp); vv[17] = bf1(hvp); \
            _Pragma("unroll") for (int q = 0; q < 4; ++q) { xv[1 + 2 * q] = bflo(rx0[q]); xv[2 + 2 * q] = bfhi(rx0[q]); xv[9 + 2 * q] = bflo(rx1[q]); xv[10 + 2 * q] = bfhi(rx1[q]); \
                                          vv[1 + 2 * q] = bflo(rv0[q]); vv[2 + 2 * q] = bfhi(rv0[q]); vv[9 + 2 * q] = bflo(rv1[q]); vv[10 + 2 * q] = bfhi(rv1[q]); } \
            float u[16]; \
            _Pragma("unroll") for (int j = 0; j < 16; ++j) { const float x1c = xa * xv[j] + xb * xv[j + 1] + xc * xv[j + 2] + xbias, vcv = va * vv[j] + vb * vv[j + 1] + vc * vv[j + 2] + vbias; u[j] = x1c * vcv; } \
            v4u o0, o1; \
            _Pragma("unroll") for (int q = 0; q < 4; ++q) { o0[q] = pk2(u[2 * q], u[2 * q + 1]); o1[q] = pk2(u[8 + 2 * q], u[9 + 2 * q]); } \
            LAS unsigned char* up = lds + H::U_OFF + (bufi) * H::UBUF + pb * H::UP + seg * 32; \
            *(LAS v4u*)up = o0; *(LAS v4u*)(up + 16) = o1; } while (0)
#define HY_MMA(par) do { bf16x8 Ar[8]; \
            if (TPW > 1) { _Pragma("unroll") for (int j = 1; j < 8; ++j) Ar[8 - j] = *(const LAS bf16x8*)(ab + 32 * (par) - 64 * j); } \
            _Pragma("unroll") for (int m = 0; m < 8; ++m) { \
                Ar[m] = *(const LAS bf16x8*)(ab + 64 * m + 32 * (par)); \
                const bf16x8 bfrag = *(const LAS bf16x8*)(ub + 64 * m + 32 * (par)); \
                _Pragma("unroll") for (int i = 0; i < TPW; ++i) acc[i] = __builtin_amdgcn_mfma_f32_32x32x16_bf16(Ar[(m - i) & 7], bfrag, acc[i], 0, 0, 0); } } while (0)
    HY_LOAD(0);
    HY_PRODUCE(0);
    if (NCH > 1) HY_LOAD(256);
    for (int ch = 0; ch < NCH; ++ch) {
        const int S0 = ch * 256, buf = ch & 1;
        __syncthreads();
        const LAS unsigned char* ub = lds + H::U_OFF + buf * H::UBUF + r * H::UP + 16 * h;
        if (ch == tw0 / 256) {
#pragma unroll
            for (int i = 0; i < TPW; ++i)
#pragma unroll
                for (int g4 = 0; g4 < 4; ++g4) { const v2u uu = *(const LAS v2u*)(lds + H::U_OFF + buf * H::UBUF + r * H::UP + 2 * ((tw0 & 255) + 32 * i + 8 * g4 + 4 * h));
                    acc[i][4 * g4] += hbias * bflo(uu.x); acc[i][4 * g4 + 1] += hbias * bfhi(uu.x); acc[i][4 * g4 + 2] += hbias * bflo(uu.y); acc[i][4 * g4 + 3] += hbias * bfhi(uu.y); }
        }
        const LAS unsigned char* ab = lds + abase + 2 * S0;
        HY_MMA(0);
        if (ch + 1 < NCH) { HY_PRODUCE(buf ^ 1); if (ch + 2 < NCH) HY_LOAD(S0 + 512); }
        HY_MMA(1);
    }
#undef HY_PRODUCE
#undef HY_MMA
#undef HY_LOAD
#pragma unroll
    for (int i = 0; i < TPW; ++i)
#pragma unroll
        for (int g = 0; g < 4; ++g) { v2u wv; wv.x = pk2(acc[i][4 * g], acc[i][4 * g + 1]); wv.y = pk2(acc[i][4 * g + 2], acc[i][4 * g + 3]);
            *(v2u*)(Y + (unsigned)(r * L + tw0 + 32 * i + 8 * g + 4 * h)) = wv; }
    __syncthreads();
}
__device__ __forceinline__ void mix_phase(const Frame& F, int layer, int what  ) {
    using attn_body::attn_unit;
    typedef attn_body::bf16 abf;
    const bf16* PX = (const bf16*)(F.ws + WS_PX); bf16* MG = (bf16*)(F.ws + WS_HX);
    const bf16* KA = (const bf16*)(F.ws + WS_KALL); const bf16* VA = (const bf16*)(F.ws + WS_VALL);
    char* shm = (char*)F.lds;
    const int nun = 2048 + (layer == 0 ? 256 : 0);
    if (what & 1) {
        float gqm = 0.f, gkm = 0.f;
        for (int d = 0; d < 64; ++d) { gqm = fmaxf(gqm, fabsf(F.in[18][layer * 64 + d])); gkm = fmaxf(gkm, fabsf(F.in[19][layer * 64 + d])); }
        const bool nomax = 11.55f * gqm * gkm <= 40.0f;
        bool pre = false; attn_body::bf16x8 qi0 = {}, qi1 = {}, qi2 = {}, qi3 = {};
        for (int U = F.vcu; U < nun; U += F.G) {
            const abf *Qp, *Kp, *Vp, *Gp; abf* Op; int nt;
            if (U < 2048) {
                const int bk = U >> 5, rem = U & 31, hq = rem >> 3, qb = rem & 7, b = bk >> 1, kvh = bk & 1, hh = kvh * 4 + hq;
                const size_t row0 = (size_t)b * LSEQ + qb * 256;
                Qp = (const abf*)(PX + row0 * NIN + 1536 + hh * 64); Kp = (const abf*)(KA + (size_t)b * 2304 * 128 + kvh * 64); Vp = (const abf*)(VA + (size_t)b * 2304 * 128 + kvh * 64);
                Op = (abf*)(MG + row0 * DM + 512 + hh * 64); Gp = (const abf*)(PX + row0 * NIN + 2304 + hh * 64); nt = 36;
            } else {
                const int uc = U - 2048, b = uc >> 3, hh = uc & 7, kvh = hh >> 2;
                const size_t row0 = (size_t)ROWS_X + b * LCTX;
                Qp = (const abf*)(PX + row0 * NIN + 1536 + hh * 64); Kp = (const abf*)(KA + ((size_t)b * 2304 + 2048) * 128 + kvh * 64); Vp = (const abf*)(VA + ((size_t)b * 2304 + 2048) * 128 + kvh * 64);
                Op = (abf*)(MG + row0 * DM + 512 + hh * 64); Gp = (const abf*)(PX + row0 * NIN + 2304 + hh * 64); nt = 4;
            }
            const abf *nK = nullptr, *nV = nullptr, *nQ = nullptr; const int Un = U + F.G;
            if (nt == 36 && Un < nun) {
                if (Un < 2048) { const int bk = Un >> 5, rem = Un & 31, hq = rem >> 3, qb = rem & 7, b = bk >> 1, kvh = bk & 1; nQ = (const abf*)(PX + ((size_t)b * LSEQ + qb * 256) * NIN + 1536 + (kvh * 4 + hq) * 64); nK = (const abf*)(KA + (size_t)b * 2304 * 128 + kvh * 64); nV = (const abf*)(VA + (size_t)b * 2304 * 128 + kvh * 64); }
                else { const int uc = Un - 2048, b = uc >> 3, kvh = (uc & 7) >> 2; nQ = (const abf*)(PX + ((size_t)ROWS_X + b * LCTX) * NIN + 1536 + (uc & 7) * 64); nK = (const abf*)(KA + ((size_t)b * 2304 + 2048) * 128 + kvh * 64); nV = (const abf*)(VA + ((size_t)b * 2304 + 2048) * 128 + kvh * 64); }
            }
            attn_body::bf16x8 qo0 = qi0, qo1 = qi1, qo2 = qi2, qo3 = qi3;
            if (nomax) { if (nt == 36) attn_unit<8, true>(Qp, NIN, Kp, Vp, 128, 36, Op, DM, Gp, NIN, shm, F.wave, nK, nV, pre, nQ, qi0, qi1, qi2, qi3, qo0, qo1, qo2, qo3); else attn_unit<8, true>(Qp, NIN, Kp, Vp, 128, 4, Op, DM, Gp, NIN, shm, F.wave, nullptr, nullptr, pre, nullptr, qi0, qi1, qi2, qi3, qo0, qo1, qo2, qo3); }
            else       { if (nt == 36) attn_unit<8, false>(Qp, NIN, Kp, Vp, 128, 36, Op, DM, Gp, NIN, shm, F.wave, nK, nV, pre, nQ, qi0, qi1, qi2, qi3, qo0, qo1, qo2, qo3); else attn_unit<8, false>(Qp, NIN, Kp, Vp, 128, 4, Op, DM, Gp, NIN, shm, F.wave, nullptr, nullptr, pre, nullptr, qi0, qi1, qi2, qi3, qo0, qo1, qo2, qo3); }
            pre = nK != nullptr; qi0 = qo0; qi1 = qo1; qi2 = qo2; qi3 = qo3;
        }
    }
    if (!(what & 2)) return;
    const float* cw = F.in[9] + layer * 3 * 768; const float* cb = F.in[10] + layer * 768;
    for (int c = F.vcu; c < 256; c += F.G) {
        const float* HF = (const float*)(F.ws + WS_HF) + (size_t)layer * 512 * 2048;
        hyena_unit<2048>(F, c, HF + (size_t)c * 2048, HF + (size_t)(256 + c) * 2048, (const bf16*)(F.ws + WS_HYT) + (size_t)c * 32 * 2048, (const bf16*)(F.ws + WS_HYT) + (size_t)(256 + c) * 32 * 2048, cw, cb, F.in[17][layer * 256 + c],
                         (bf16*)(F.ws + WS_YHT) + (size_t)c * 32 * 2048);
        if (layer == 0) {
            const float* HFC = (const float*)(F.ws + WS_HF) + (size_t)2 * 512 * 2048;
            hyena_unit<256>(F, c, HFC + (size_t)c * 256, HFC + (size_t)(256 + c) * 256, (const bf16*)(F.ws + WS_HYTC) + (size_t)c * 32 * 256, (const bf16*)(F.ws + WS_HYTC) + (size_t)(256 + c) * 32 * 256, cw, cb, F.in[17][layer * 256 + c],
                            (bf16*)(F.ws + WS_YHTC) + (size_t)c * 32 * 256);
        }
    }
}

constexpr int MG_VT = 0, MG_P = 528, MG_DT = 41728, MG_YL = 75520, MG_WL = 109312;
__device__ __forceinline__ void merge_phase(const Frame& F, int layer, int parts = 3  ) {
    LAS unsigned char* lds = F.lds; const int w = F.wave;
    const bf16* PX = (const bf16*)(F.ws + WS_PX); bf16* MG = (bf16*)(F.ws + WS_HX);
    const bf16* PWT = (const bf16*)(F.ws + WS_PWT) + (size_t)layer * 4 * 64 * 64;
    const float* pscale = F.in[8] + layer * 256; const float* cw = F.in[9] + layer * 3 * 768; const float* cb = F.in[10] + layer * 768; const float* hbias = F.in[17] + layer * 256;
    const int nst = (layer == 0 ? MT : ROWS_X) / 64;
    { LAS float* WL = (LAS float*)(lds + MG_WL); const int tid = F.tid;
      for (int i = tid; i < 3328; i += 512) WL[i] = i < 2304 ? cw[i] : (i < 3072 ? cb[i - 2304] : hbias[i - 3072]); }
    __syncthreads();
    v4u sv[5], yv4[4];
#define MG_STAGE_LOAD(stv) do { const int ln_ = fresh_lane(), td_ = w * 64 + ln_; const int R0_ = (stv) * 64; int b_, t0_, Lq_; unsigned seq0_; const bf16* YH_; \
        if (R0_ < ROWS_X) { b_ = R0_ >> 11; t0_ = R0_ & 2047; Lq_ = LSEQ; seq0_ = (unsigned)(b_ * LSEQ); YH_ = (const bf16*)(F.ws + WS_YHT); } \
        else { const int rc_ = R0_ - ROWS_X; b_ = rc_ >> 8; t0_ = rc_ & 255; Lq_ = LCTX; seq0_ = (unsigned)(ROWS_X + b_ * LCTX); YH_ = (const bf16*)(F.ws + WS_YHTC); } \
        _Pragma("unroll") for (int k = 0; k < 5; ++k) { const int id = td_ + 512 * k, q = id >> 5, ch = id & 31, p = t0_ - 8 + q; \
            sv[k] = (v4u){0u, 0u, 0u, 0u}; if ((parts & 1) && id < 79 * 32 && p >= 0 && p < Lq_) sv[k] = *(const v4u*)(PX + ((seq0_ + (unsigned)p) * (unsigned)NIN + 8u * ch)); } \
        { const int c = td_ >> 1, hs = td_ & 1; const bf16* yp = YH_ + (unsigned)((c * 32 + b_) * Lq_ + t0_ + 32 * hs); \
            _Pragma("unroll") for (int k = 0; k < 4; ++k) yv4[k] = (parts & 2) ? *(const v4u*)(yp + 8 * k) : (v4u){0u, 0u, 0u, 0u}; } } while (0)
    if (F.vcu < nst) MG_STAGE_LOAD(F.vcu);
    for (int st = F.vcu; st < nst; st += F.G) {
        const int lane = fresh_lane(), tid = w * 64 + lane, cg8 = (tid & 31) * 8;
        const int R0 = st * 64; int b, t0, Lq; unsigned seq0;
        if (R0 < ROWS_X) { b = R0 >> 11; t0 = R0 & 2047; Lq = LSEQ; seq0 = (unsigned)(b * LSEQ); }
        else { const int rc = R0 - ROWS_X; b = rc >> 8; t0 = rc & 255; Lq = LCTX; seq0 = (unsigned)(ROWS_X + b * LCTX); }
        (void)seq0; (void)b;
        const int pg_g = w >> 1, pg_rt = w & 1, pg_r = lane & 31, pg_h = lane >> 5;
        const unsigned prow = (unsigned)(R0 + 32 * pg_rt + pg_r);
        v4u x0r[2][3], gr[2];
#define MG_ITEM_LOAD(q) do { const int tok = (tid >> 5) + 16 * (q); const int t = t0 + tok; const unsigned grow = (unsigned)(R0 + tok); \
            const bf16* rowp = PX + (grow * (unsigned)NIN + 512u + cg8); \
            _Pragma("unroll") for (int j = 0; j < 3; ++j) { const bool ok = (t + j - 1 >= 0) && (t + j - 1 < Lq); const bf16* rp = rowp + (j - 1) * NIN; \
                x0r[(q) & 1][j] = ok ? *(const v4u*)rp : (v4u){0u, 0u, 0u, 0u}; } \
            gr[(q) & 1] = *(const v4u*)(rowp + 768); } while (0)
        if (parts & 2) { MG_ITEM_LOAD(0); MG_ITEM_LOAD(1); }
#if 0
        for (int q = 0; q < 4; ++q) { const int tok = (tid >> 5) + 16 * q; const int t = t0 + tok; const unsigned grow = (unsigned)(R0 + tok);
            const bf16* rowp = PX + (grow * (unsigned)NIN + 512u + cg8);
#pragma unroll
            for (int j = 0; j < 3; ++j) { const bool ok = (t + j - 1 >= 0) && (t + j - 1 < Lq); const bf16* rp = rowp + (j - 1) * NIN;
                x0r[q][j] = ok ? *(const v4u*)rp : (v4u){0u, 0u, 0u, 0u}; x1r[q][j] = ok ? *(const v4u*)(rp + 256) : (v4u){0u, 0u, 0u, 0u}; vr[q][j] = ok ? *(const v4u*)(rp + 512) : (v4u){0u, 0u, 0u, 0u}; }
            gr[q] = *(const v4u*)(rowp + 768); }
#endif
#pragma unroll
        for (int k = 0; k < 5; ++k) { const int id = tid + 512 * k, q = id >> 5, ch = id & 31; if (id < 79 * 32) *(LAS v4u*)(lds + MG_VT + q * MG_P + 16 * ch) = sv[k]; }
        { const int c = tid >> 1, hs = tid & 1;
#pragma unroll
            for (int k = 0; k < 4; ++k) {
#pragma unroll
                for (int q = 0; q < 4; ++q) { *(LAS unsigned short*)(lds + MG_YL + (32 * hs + 8 * k + 2 * q) * MG_P + 2 * c) = (unsigned short)(yv4[k][q] & 0xffffu);
                                              *(LAS unsigned short*)(lds + MG_YL + (32 * hs + 8 * k + 2 * q + 1) * MG_P + 2 * c) = (unsigned short)(yv4[k][q] >> 16); } } }
        __syncthreads();
        asm volatile("" ::: "memory");
        v2u pgt[2][4];
#pragma unroll
        for (int jt = 0; jt < 2; ++jt)
#pragma unroll
            for (int G4 = 0; G4 < 4; ++G4) pgt[jt][G4] = *(const v2u*)(PX + (prow * (unsigned)NIN + 256u + 64 * pg_g + 32 * jt + 8 * G4 + 4 * pg_h));
        if (parts & 1) { const int cp = tid & 127, quarter = tid >> 7, g = cp >> 5, hw = 1 << g;
            const LAS unsigned char* vc = lds + MG_VT + 4 * cp;
            const int j0 = 16 * quarter; float S0 = 0.f, S1 = 0.f;
            for (int q = j0 + 8 - hw; q < j0 + 8 + hw; ++q) { const unsigned u = *(const LAS unsigned*)(vc + q * MG_P); S0 += bflo(u); S1 += bfhi(u); }
#pragma unroll 4
            for (int j = j0; j < j0 + 16; ++j) {
                const int t = t0 + j; const int lo = max(t - hw, 0), hi = min(t + hw, Lq);
                const float rc = __builtin_amdgcn_rcpf((float)(hi - lo));
                const unsigned uc = *(const LAS unsigned*)(vc + (j + 8) * MG_P);
                *(LAS unsigned*)(lds + MG_DT + j * MG_P + 4 * cp) = pk2(S0 * rc - bflo(uc), S1 * rc - bfhi(uc));
                if (j + 1 < j0 + 16) { const unsigned ua = *(const LAS unsigned*)(vc + (j + 8 + hw) * MG_P), ub = *(const LAS unsigned*)(vc + (j + 8 - hw) * MG_P); S0 += bflo(ua) - bflo(ub); S1 += bfhi(ua) - bfhi(ub); }
            } }
        __syncthreads();
#define MG_ITEM_DO(q) do { const int tok = (tid >> 5) + 16 * (q); const unsigned grow = (unsigned)(R0 + tok); \
            const v4u yr = *(const LAS v4u*)(lds + MG_YL + tok * MG_P + 2 * cg8); v4u o; \
            _Pragma("unroll") for (int hf = 0; hf < 2; ++hf) { \
                const LAS float* WL = (const LAS float*)(lds + MG_WL) + cg8 + 4 * hf; \
                f32x4 a0 = *(const LAS f32x4*)(WL + 2304); \
                _Pragma("unroll") for (int j = 0; j < 3; ++j) { const f32x4 w0 = *(const LAS f32x4*)(WL + j * 768); \
                    const unsigned xa = x0r[(q) & 1][j][2 * hf], xb = x0r[(q) & 1][j][2 * hf + 1]; \
                    a0 += w0 * (f32x4){bflo(xa), bfhi(xa), bflo(xb), bfhi(xb)}; } \
                const unsigned y0 = yr[2 * hf], y1 = yr[2 * hf + 1], g0 = gr[(q) & 1][2 * hf], g1 = gr[(q) & 1][2 * hf + 1]; \
                const f32x4 yv = (f32x4){bflo(y0), bfhi(y0), bflo(y1), bfhi(y1)}, gv = (f32x4){silu_fast(bflo(g0)), silu_fast(bfhi(g0)), silu_fast(bflo(g1)), silu_fast(bfhi(g1))}; \
                const f32x4 res = a0 * yv * gv; \
                o[2 * hf] = pk2(res[0], res[1]); o[2 * hf + 1] = pk2(res[2], res[3]); } \
            asm volatile("" ::: "memory"); \
            *(v4u*)(MG + (grow * (unsigned)DM + 256u + cg8)) = o; } while (0)
        if (st + F.G < nst) MG_STAGE_LOAD(st + F.G);
        if (parts & 2) { MG_ITEM_DO(0); MG_ITEM_LOAD(2); MG_ITEM_DO(1); MG_ITEM_LOAD(3); }
        if (parts & 1) {
#pragma unroll
            for (int jt = 0; jt < 2; ++jt) {
                f32x16 acc = f32x16{};
#pragma unroll
                for (int kk = 0; kk < 4; ++kk) {
                    const bf16x8 a = *(const LAS bf16x8*)(lds + MG_DT + (32 * pg_rt + pg_r) * MG_P + 2 * (64 * pg_g + 16 * kk + 8 * pg_h));
                    const bf16x8 bfr = *(const bf16x8*)(PWT + ((size_t)pg_g * 64 + 32 * jt + pg_r) * 64 + 16 * kk + 8 * pg_h);
                    acc = __builtin_amdgcn_mfma_f32_32x32x16_bf16(bfr, a, acc, 0, 0, 0);
                }
#pragma unroll
                for (int G4 = 0; G4 < 4; ++G4) { const int col = 64 * pg_g + 32 * jt + 8 * G4 + 4 * pg_h;
                    const f32x4 ps = *(const f32x4*)(pscale + col); const v2u gt = pgt[jt][G4];
                    v2u o; o.x = pk2(acc[4 * G4] * ps[0] * silu_fast(bflo(gt.x)), acc[4 * G4 + 1] * ps[1] * silu_fast(bfhi(gt.x))); o.y = pk2(acc[4 * G4 + 2] * ps[2] * silu_fast(bflo(gt.y)), acc[4 * G4 + 3] * ps[3] * silu_fast(bfhi(gt.y)));
                    *(v2u*)(MG + (prow * (unsigned)DM + col)) = o; }
            } }
        if (parts & 2) { MG_ITEM_DO(2); MG_ITEM_DO(3); }
#undef MG_ITEM_DO
#undef MG_ITEM_LOAD
#undef MG_STAGE_LOAD
        __syncthreads();
    }
}
#if MK_CHECK
constexpr int CW_CHKFLAG = 3600;
__device__ __forceinline__ void chk_fail(const Frame& F, int code) { atomicAdd((unsigned*)(F.ws + WS_CTL) + CW_CHKFLAG, 1u); atomicMax((unsigned*)(F.ws + WS_CTL) + CW_CHKFLAG + 1, (unsigned)code); }
__device__ __forceinline__ unsigned hash_u(unsigned x) { x ^= x >> 16; x *= 0x7feb352du; x ^= x >> 15; x *= 0x846ca68bu; x ^= x >> 16; return x; }
__device__ __forceinline__ void check_phase(const Frame& F, int which, int layer) {
    const int gw = F.vcu * NWAVES + F.wave, lane = F.lane;
    const bf16* PX = (const bf16*)(F.ws + WS_PX); const bf16* MG = (const bf16*)(F.ws + WS_HX);
    const bf16* KA = (const bf16*)(F.ws + WS_KALL); const bf16* VA = (const bf16*)(F.ws + WS_VALL);
    const unsigned hsh = hash_u((unsigned)gw * 2654435761u + (unsigned)which * 97u + (unsigned)layer * 31u);
    if (which == 1) {
        const bool isctx = (gw & 1) != 0; if (isctx && layer == 1 && false) return;
        const int b = (hsh >> 3) & 31, t = isctx ? ((hsh >> 8) & 255) : ((hsh >> 8) & 2047), kvh = (hsh >> 20) & 1;
        const size_t row = isctx ? (size_t)ROWS_X + b * LCTX + t : (size_t)b * LSEQ + t;
        const bf16* hx = (const bf16*)(F.ws + WS_HX) + row * DM; const float* W = F.in[6] + (size_t)layer * 1024 * NIN;
        float kd = 0.f, vd = 0.f, pd = 0.f; const int pcol = (hsh >> 22) & 192;
        for (int k = 0; k < 1024; ++k) { const float a = bf1(hx[k]); kd = fmaf(a, W[(size_t)k * NIN + 2048 + 64 * kvh + lane], kd); vd = fmaf(a, W[(size_t)k * NIN + 2176 + 64 * kvh + lane], vd); pd = fmaf(a, W[(size_t)k * NIN + pcol + lane], pd); }
        const float rs = 1.0f / sqrtf(wave_sum(kd * kd) * (1.0f / 64.0f) + 1e-6f);
        float kn = kd * rs * F.in[19][layer * 64 + lane];
        if (!isctx) {
            const int g = lane >> 5, i = lane & 15, pos = g == 0 ? (t >> 6) : (t & 63); const float inv = exp2f(-(float)i * (13.287712379549449f / 16.0f)); const float ang = (float)pos * inv, cs = cosf(ang), sn = sinf(ang);
            const float other = __shfl_xor(kn, 16); kn = ((lane >> 4) & 1) ? (other * sn + kn * cs) : (kn * cs - other * sn); }
        const size_t kvrow = ((size_t)b * 2304 + (isctx ? 2048 + t : t)) * 128 + 64 * kvh + lane;
        const float ka = bf1(KA[kvrow]), va = bf1(VA[kvrow]);
        if (fabsf(ka - kn) > 0.02f * fabsf(kn) + 0.02f) chk_fail(F, 10 + layer);
        if (fabsf(va - vd) > 0.02f * fabsf(vd) + 0.02f) chk_fail(F, 12 + layer);
        if (!(isctx && layer == 1)) {
            const int hq = (hsh >> 26) & 7; float qd = 0.f;
            for (int k = 0; k < 1024; ++k) qd = fmaf(bf1(hx[k]), W[(size_t)k * NIN + 1536 + 64 * hq + lane], qd);
            const float rq = 1.0f / sqrtf(wave_sum(qd * qd) * (1.0f / 64.0f) + 1e-6f);
            float qn = qd * rq * F.in[18][layer * 64 + lane];
            if (!isctx) { const int g = lane >> 5, i = lane & 15, pos = g == 0 ? (t >> 6) : (t & 63); const float inv = exp2f(-(float)i * (13.287712379549449f / 16.0f)); const float ang = (float)pos * inv, cs = cosf(ang), sn = sinf(ang);
                const float other = __shfl_xor(qn, 16); qn = ((lane >> 4) & 1) ? (other * sn + qn * cs) : (qn * cs - other * sn); }
            qn *= 0.125f * 1.4426950408889634f;
            const float qa = bf1(PX[row * NIN + 1536 + 64 * hq + lane]);
            if (fabsf(qa - qn) > 0.02f * fabsf(qn) + 0.004f) chk_fail(F, 16 + layer); }
        if (!(isctx && layer == 1)) { const float pa = bf1(PX[row * NIN + pcol + lane]); if (fabsf(pa - pd) > 0.02f * fabsf(pd) + 0.02f) chk_fail(F, 14 + layer); }
    } else if (which == 2) {
        if ((gw & 1) == 0) {
            const bool isctx = layer == 0 && (gw & 6) == 0;
            const int b = (hsh >> 3) & 31, t = isctx ? ((hsh >> 8) & 255) : ((hsh >> 8) & 2047), hh = (hsh >> 20) & 7, kvh = hh >> 2;
            const size_t row = isctx ? (size_t)ROWS_X + b * LCTX + t : (size_t)b * LSEQ + t;
            const int j0 = isctx ? 2048 : 0, nk = isctx ? 256 : 2304;
            const float qd = bf1(PX[row * NIN + 1536 + 64 * hh + lane]);
            float m = -1e30f, l = 0.f, o = 0.f;
            for (int j = 0; j < nk; ++j) { const size_t kr = ((size_t)b * 2304 + j0 + j) * 128 + 64 * kvh + lane;
                const float s = wave_sum(qd * bf1(KA[kr])), mn = fmaxf(m, s), f = exp2f(m - mn), p = exp2f(s - mn);
                o = o * f + p * bf1(VA[kr]); l = l * f + p; m = mn; }
            const float mine = o;
            const float gt_ = bf1(PX[row * NIN + 2304 + 64 * hh + lane]);
            const float ref = mine / l * (gt_ / (1.0f + __expf(-gt_))), act = bf1(MG[row * DM + 512 + 64 * hh + lane]);
            if (fabsf(act - ref) > 0.03f * fabsf(ref) + 0.002f) chk_fail(F, 20 + layer + (isctx ? 2 : 0));
        } else {
            const bool isctx = layer == 0 && (gw & 6) == 0; const int L = isctx ? 256 : 2048;
            const int c = (hsh >> 3) & 255, b = (hsh >> 11) & 31, t = (hsh >> 16) & (L - 1);
            const float* HF = (const float*)(F.ws + WS_HF) + (isctx ? (size_t)2 * 512 * 2048 : (size_t)layer * 512 * 2048);
            const float* hf = HF + (size_t)c * L; const float* hb = HF + (size_t)(256 + c) * L;
            float nrm = 0.f; for (int i = lane; i < L; i += 64) { nrm += fabsf(hf[i]); if (i > 0) nrm += fabsf(hb[i]); }
            nrm = wave_sum(nrm);
            const float* cw = F.in[9] + layer * 3 * 768; const float* cb = F.in[10] + layer * 768;
            const bf16* XT = isctx ? (const bf16*)(F.ws + WS_HYTC) : (const bf16*)(F.ws + WS_HYT);
            float acc = 0.f;
            for (int s = lane; s < L; s += 64) { float x1c = cb[256 + c], vc = cb[512 + c];
                for (int j = 0; j < 3; ++j) { const int ss = s + j - 1; if (ss >= 0 && ss < L) { x1c = fmaf(cw[j * 768 + 256 + c], bf1(XT[((size_t)c * 32 + b) * L + ss]), x1c); vc = fmaf(cw[j * 768 + 512 + c], bf1(XT[((size_t)(256 + c) * 32 + b) * L + ss]), vc); } }
                if (s == t) acc = fmaf(x1c * vc, nrm * F.in[17][layer * 256 + c], acc);
                const int n = t - s; const float g = n >= 0 ? hf[n] : hb[-n]; acc = fmaf(x1c * vc, g, acc); }
            const float ref = wave_sum(acc) / nrm;
            const bf16* YH = isctx ? (const bf16*)(F.ws + WS_YHTC) : (const bf16*)(F.ws + WS_YHT);
            const float act = bf1(YH[((size_t)c * 32 + b) * L + t]);
            if (lane == 0 && fabsf(act - ref) > 0.02f * fabsf(ref) + 0.0007f) chk_fail(F, 30 + layer + (isctx ? 2 : 0));
        }
    } else if (which == 3) {
        const bool isctx = layer == 0 && (gw & 3) == 0; const int L = isctx ? 256 : 2048;
        const int b = (hsh >> 3) & 31, t = (gw & 4) ? ((hsh >> 8) & 15) * ((gw & 8) ? 1 : -1) + ((gw & 8) ? 0 : L - 1) : ((hsh >> 8) & (L - 1));
        const size_t seq0 = isctx ? (size_t)ROWS_X + b * LCTX : (size_t)b * LSEQ, row = seq0 + t;
#ifndef CHK3
#define CHK3 0xff
#endif
        if (!(CHK3 & 4) && isctx) return; if (!(CHK3 & 8) && !isctx) return; if (!(CHK3 & 16) && (gw & 4)) return; if (!(CHK3 & 32) && !(gw & 4)) return;
        if ((gw & 16) && !(CHK3 & 1)) return; if (!(gw & 16) && !(CHK3 & 2)) return;
        if (gw & 16) {
            const int g = (hsh >> 24) & 3, hw = 1 << g, lo = max(t - hw, 0), hi = min(t + hw, L);
            float m = 0.f; for (int p = lo; p < hi; ++p) m += bf1(PX[(seq0 + p) * NIN + 64 * g + lane]);
            const float d = m / (float)(hi - lo) - bf1(PX[row * NIN + 64 * g + lane]);
            const float* pw = F.in[7] + (size_t)(layer * 4 + g) * 64 * 64;
            float mine = 0.f;
            for (int dout = 0; dout < 64; ++dout) { const float y = wave_sum(d * pw[lane * 64 + dout]); if (dout == lane) mine = y; }
            const float pg_ = bf1(PX[row * NIN + 256 + 64 * g + lane]);
            const float ref = mine * F.in[8][layer * 256 + 64 * g + lane] * (pg_ / (1.0f + __expf(-pg_))), act = bf1(MG[row * DM + 64 * g + lane]);
            if (fabsf(act - ref) > 0.03f * fabsf(ref) + 0.03f) chk_fail(F, 40 + layer + (isctx ? 2 : 0));
        } else {
            const int c = ((hsh >> 24) & 3) * 64 + lane;
            const float* cw = F.in[9] + layer * 3 * 768; const float* cb = F.in[10] + layer * 768;
            float a0 = cb[c];
            for (int j = 0; j < 3; ++j) { const int ss = t + j - 1; if (ss >= 0 && ss < L) { const bf16* rp = PX + (seq0 + ss) * NIN; a0 = fmaf(cw[j * 768 + c], bf1(rp[512 + c]), a0); } }
            const bf16* YH = isctx ? (const bf16*)(F.ws + WS_YHTC) : (const bf16*)(F.ws + WS_YHT);
            const float y = bf1(YH[((size_t)c * 32 + b) * L + t]);
            const float hg_ = bf1(PX[row * NIN + 1280 + c]);
            const float ref = a0 * y * (hg_ / (1.0f + __expf(-hg_))), act = bf1(MG[row * DM + 256 + c]);
            if (fabsf(act - ref) > 0.02f * fabsf(ref) + 0.01f) chk_fail(F, 44 + layer + (isctx ? 2 : 0));
        }
    } else if (which == 4) {
        if (gw >= 64) return;
        const bool isctx = layer == 0 && (gw & 1) != 0;
        const int b = (hsh >> 3) & 31, t = isctx ? ((hsh >> 8) & 255) : ((hsh >> 8) & 2047);
        const size_t row = isctx ? (size_t)ROWS_X + b * LCTX + t : (size_t)b * LSEQ + t;
        const float* W = F.in[20] + (size_t)layer * 1024 * 1024; const bf16* mrow = MG + row * DM;
        f32x4 acc[4] = {};
        for (int k = 0; k < 1024; ++k) { const float a = bf1(mrow[k]);
#pragma unroll
            for (int j = 0; j < 4; ++j) acc[j] += *(const f32x4*)(W + (size_t)k * 1024 + 4 * lane + 256 * j) * a; }
        const float* gate = (const float*)(F.ws + WS_MOD) + ((size_t)layer * 33 + (isctx ? 32 : b)) * 3072 + 2048;
        const bf16* gy = (const bf16*)(F.ws + (layer == 0 ? WS_GY0 : WS_GY)) + row * DM;
#pragma unroll
        for (int j = 0; j < 4; ++j)
#pragma unroll
            for (int e = 0; e < 4; ++e) { const int col = 4 * lane + 256 * j + e; const float ref = acc[j][e] * gate[col], act = bf1(gy[col]); if (fabsf(act - ref) > 0.02f * fabsf(ref) + 0.004f) chk_fail(F, 50 + layer + (isctx ? 2 : 0)); }
    } else if (which == 5) {
        const bool isctx = (gw & 1) != 0;
        const int b = (hsh >> 3) & 31, t = isctx ? ((hsh >> 8) & 255) : ((hsh >> 8) & 2047);
        const size_t row = isctx ? (size_t)ROWS_X + b * LCTX + t : (size_t)b * LSEQ + t;
        const float* src = isctx ? F.in[2] + (row - ROWS_X) * DM : F.in[0] + row * DM; const bf16* gy = (const bf16*)(F.ws + WS_GY0) + row * DM;
        const float* MOD1 = (const float*)(F.ws + WS_MOD) + ((size_t)33 + (isctx ? 32 : b)) * 3072;
        float v[16]; float s = 0.f;
#pragma unroll
        for (int i = 0; i < 16; ++i) { const int col = lane + 64 * i; v[i] = 1.4142135623730951f * src[col] + bf1(gy[col]); s += v[i]; }
        float mean = wave_sum(s) * (1.f / DM), s2 = 0.f;
#pragma unroll
        for (int i = 0; i < 16; ++i) { v[i] -= mean; s2 += v[i] * v[i]; }
        float rstd = 1.f / sqrtf(wave_sum(s2) * (1.f / DM) + LN_EPS); s = 0.f;
#pragma unroll
        for (int i = 0; i < 16; ++i) { const int col = lane + 64 * i; v[i] = v[i] * rstd * F.in[21][col] + F.in[22][col]; s += v[i];
            }
        mean = wave_sum(s) * (1.f / DM); s2 = 0.f;
#pragma unroll
        for (int i = 0; i < 16; ++i) { v[i] -= mean; s2 += v[i] * v[i]; }
        rstd = 1.f / sqrtf(wave_sum(s2) * (1.f / DM) + LN_EPS);
#pragma unroll
        for (int i = 0; i < 16; ++i) { const int col = lane + 64 * i; const float ref = v[i] * rstd * (1.f + MOD1[1024 + col]) + MOD1[col], act = bf1(((const bf16*)(F.ws + WS_HX))[row * DM + col]);
            if (fabsf(act - ref) > 0.01f * fabsf(ref) + 0.01f) chk_fail(F, 62 + (isctx ? 1 : 0)); }
    }
}
#endif
#ifndef MK_MULTI
#define MK_MULTI 0
#endif
struct Args { const float* in[23]; float* out; unsigned char* ws; int ph_lo, ph_hi; };
constexpr int N_PHASES = 12;

__global__ void __launch_bounds__(NWAVES * 64, 2) mega_fwd(Args args) {
    extern __shared__ __attribute__((aligned(16))) unsigned char lds_raw[];
    Frame F;
    F.lds = (LAS unsigned char*)lds_raw;
    F.G = gridDim.x; { const int bx = blockIdx.x; F.vcu = (F.G % 8 == 0) ? (bx % 8) * (F.G / 8) + bx / 8 : bx; }
    F.in = args.in;
    F.wave = __builtin_amdgcn_readfirstlane((int)threadIdx.x >> 6);
    const int lo = args.ph_lo, hi = args.ph_hi;
#if MK_MULTI
#define GRID_SYNC() do { } while (0)
#define GRID_SYNC_CG() do { } while (0)
#else
    volatile LAS unsigned* misc = (volatile LAS unsigned*)(F.lds + MISC_OFF);
    { const int l_ = fresh_lane(); if (F.wave == 0 && l_ < 16) misc[l_] = 0u; }
    __syncthreads();
    XcdBarrier bar = xcd_barrier_post((unsigned*)(args.ws + WS_CTL), misc, F.wave);
#define GRID_SYNC() xcd_barrier(bar)
#define GRID_SYNC_CG() do { __threadfence(); cg::this_grid().sync(); } while (0)
#endif
#ifndef PH_MASK
#define PH_MASK 0xfff
#endif
#define PH_ON(k) ((PH_MASK >> (k)) & 1)
#ifndef DUP_MASK
#define DUP_MASK 0
#endif
#define DUP(k) ((DUP_MASK >> (k)) & 1)
#define IN(k) (lo <= (k) && (k) < hi)
#ifndef SEAM0_CG
#define SEAM0_CG 0
#endif
#define SEAM(k) do { if (IN(k) && IN((k) + 1)) { if (SEAM0_CG && (k) == 0) GRID_SYNC_CG(); else GRID_SYNC(); } } while (0)
#define FRESH() do { F.lane = fresh_lane(); F.tid = F.wave * 64 + F.lane; F.ws = args.ws; F.out = args.out; } while (0)
    if (IN(0) && PH_ON(0)) { FRESH(); p0a_phase(F); if (DUP(0)) { __syncthreads(); p0a_phase(F); } }
    SEAM(0);
    if (IN(1) && PH_ON(1)) { FRESH(); mod_finalize(F); ln_phase(F, 0); if (DUP(1)) ln_phase(F, 0); }
    SEAM(1);
#pragma unroll 1
    for (int layer = 0; layer < 2; ++layer) {
        const int p0 = 2 + 5 * layer;
        if (IN(p0) && PH_ON(2)) { FRESH();
            pg8::Gemm g{(const pg8::bf16_t*)(F.ws + WS_HX), (const pg8::bf16_t*)(F.ws + WS_WIN) + (size_t)layer * NIN * 1024, MT, NIN, DM};
            pg8::GridOrder S;
            if (layer == 0) S = pg8::GridOrder{MT / 256, NIN / 256, 0, 0, 0, F.G, (int)blockIdx.x};
            else S = pg8::GridOrder{ROWS_X / 256, NIN / 256, ROWS_C / 256, ROWS_X / 256, 8, F.G, (int)blockIdx.x};
            pg8::EpiIn E{(pg8::bf16_t*)(F.ws + WS_PX), (pg8::bf16_t*)(F.ws + WS_KALL), (pg8::bf16_t*)(F.ws + WS_VALL), (pg8::bf16_t*)(F.ws + WS_HYT), (pg8::bf16_t*)(F.ws + WS_HYTC),
                          F.in[18] + layer * 64, F.in[19] + layer * 64, (const float*)(F.ws + WS_ROPE), F.lds + STG_OFF};
#ifdef DUP_DUMMY
            { pg8::EpiDummy ED{(pg8::bf16_t*)(F.ws + WS_PX), NIN}; pg8::gemm_phase<pg8::EpiDummy, pg8::GridOrder, true, true>(F.lds, g, S, ED, F.wave); __syncthreads(); }
#endif
            pg8::gemm_phase<pg8::EpiIn, pg8::GridOrder, true, true>(F.lds, g, S, E, F.wave);
            if (DUP(2)) { __syncthreads(); pg8::gemm_phase<pg8::EpiIn, pg8::GridOrder, true, true>(F.lds, g, S, E, F.wave); }
#ifdef DUP_PN
            if (layer == 0) { __syncthreads(); pg8::GridOrder S2{0, NIN / 256, MT / 256, 0, DUP_PN, F.G, (int)blockIdx.x}; pg8::gemm_phase<pg8::EpiIn, pg8::GridOrder, true, true>(F.lds, g, S2, E, F.wave); }
#endif
            }
        SEAM(p0);
#if MK_CHECK
        if (MK_CHECK & 1) { FRESH(); check_phase(F, 1, layer); GRID_SYNC(); }
#endif
        if (IN(p0 + 1) && PH_ON(3)) { FRESH(); mix_phase(F, layer, 3); if (DUP(3)) mix_phase(F, layer, 1); if (DUP(7)) mix_phase(F, layer, 2); }
        SEAM(p0 + 1);
#if MK_CHECK
        if (MK_CHECK & 2) { FRESH(); check_phase(F, 2, layer); GRID_SYNC(); }
#endif
        if (IN(p0 + 2) && PH_ON(4)) { FRESH(); merge_phase(F, layer); if (DUP(4)) merge_phase(F, layer); if (DUP(8)) merge_phase(F, layer, 1); if (DUP(9)) merge_phase(F, layer, 2); }
        SEAM(p0 + 2);
#if MK_CHECK
        if (MK_CHECK & 4) { FRESH(); check_phase(F, 3, layer); GRID_SYNC(); }
#endif
        if (IN(p0 + 3) && PH_ON(5)) { FRESH();
            pg8::Gemm g{(const pg8::bf16_t*)(F.ws + WS_HX), (const pg8::bf16_t*)(F.ws + WS_WOUT) + (size_t)layer * 1024 * 1024, MT, DM, DM};
            pg8::GridOrder S{(layer == 0 ? MT : ROWS_X) / 256, DM / 256, 0, 0, 0, F.G, (int)blockIdx.x};
            pg8::EpiOut E{(pg8::bf16_t*)(F.ws + (layer == 0 ? WS_GY0 : WS_GY)), (const float*)(F.ws + WS_MOD) + (size_t)layer * 33 * 3072};
            pg8::gemm_phase<pg8::EpiOut, pg8::GridOrder, true, true>(F.lds, g, S, E, F.wave);
            if (DUP(5)) { __syncthreads(); pg8::gemm_phase<pg8::EpiOut, pg8::GridOrder, true, true>(F.lds, g, S, E, F.wave); } }
        SEAM(p0 + 3);
#if MK_CHECK
        if (MK_CHECK & 8) { FRESH(); check_phase(F, 4, layer); GRID_SYNC(); }
#endif
        if (IN(p0 + 4) && PH_ON(6)) { FRESH(); ln_phase(F, layer + 1); }
        SEAM(p0 + 4);
#if MK_CHECK
        if ((MK_CHECK & 16) && layer == 0) { FRESH(); check_phase(F, 5, layer); GRID_SYNC(); }
#endif
    }
#undef IN
#undef SEAM
#undef FRESH
}

extern "C" void kernel_launch(void* const* d_in, const int* in_sizes, int n_in, void* d_out, int out_size, void* d_ws, size_t ws_size, hipStream_t stream) {
    static int grid = 0;
    if (grid == 0) {
        if (n_in != 23 || out_size != ROWS_X * DM || ws_size < WS_END) { fprintf(stderr, "kernel_launch: unexpected shapes (n_in %d, out %d, ws %zu)\n", n_in, out_size, ws_size); grid = -1; return; }
        int dev = 0, cus = 0, per_cu = 0;
        hipGetDevice(&dev); hipDeviceGetAttribute(&cus, hipDeviceAttributeMultiprocessorCount, dev);
        hipFuncSetAttribute((const void*)mega_fwd, hipFuncAttributeMaxDynamicSharedMemorySize, LDS_BYTES);
        hipOccupancyMaxActiveBlocksPerMultiprocessor(&per_cu, (const void*)mega_fwd, NWAVES * 64, LDS_BYTES);
        (void)hipGetLastError();
        if (per_cu < 1) { fprintf(stderr, "kernel_launch: occupancy query reports %d blocks per CU\n", per_cu); per_cu = 1; }
        grid = 256; while (grid > cus) grid >>= 1;
    }
    if (grid < 0) return;
#if !MK_MULTI
    if (hipMemsetAsync((char*)d_ws + WS_CTL, 0, 16384, stream) != hipSuccess) { fprintf(stderr, "kernel_launch: memset of the barrier words failed\n"); return; }
#endif
    Args a{};
    for (int i = 0; i < 23; ++i) a.in[i] = (const float*)d_in[i];
    a.out = (float*)d_out; a.ws = (unsigned char*)d_ws;
#if MK_MULTI
    for (int ph = 0; ph < N_PHASES; ++ph) { a.ph_lo = ph; a.ph_hi = ph + 1; hipLaunchKernelGGL(mega_fwd, dim3(grid), dim3(NWAVES * 64), LDS_BYTES, stream, a); }
#else
    a.ph_lo = 0; a.ph_hi = N_PHASES;
    void* kargs[] = {&a};
    hipError_t e = hipLaunchCooperativeKernel((const void*)mega_fwd, dim3(grid), dim3(NWAVES * 64), kargs, LDS_BYTES, stream);
    if (e != hipSuccess) fprintf(stderr, "cooperative launch failed: %s (grid %d)\n", hipGetErrorString(e), grid);
#endif
}
```

```cpp
#include <hip/hip_runtime.h>
#include <hip/hip_cooperative_groups.h>
#include <hip/hip_bf16.h>
#include <cstdio>
#include <cstdint>
#include <cmath>
namespace cg = cooperative_groups;
#ifndef MK_CHECK
#define MK_CHECK 0
#endif
__device__ __forceinline__ int fresh_lane() { int l; asm volatile("v_mbcnt_lo_u32_b32 %0, -1, 0\n\tv_mbcnt_hi_u32_b32 %0, -1, %0" : "=v"(l)); return l; }
__device__ __forceinline__ float xor16_f(float v) { return __int_as_float(__builtin_amdgcn_ds_swizzle(__float_as_int(v), 0x401F)); }
__device__ __forceinline__ float sum_xor32(float v) { auto r = __builtin_amdgcn_permlane32_swap(__float_as_uint(v), __float_as_uint(v), false, false); return __uint_as_float(r[0]) + __uint_as_float(r[1]); }
__device__ __forceinline__ float max_xor32(float v) { auto r = __builtin_amdgcn_permlane32_swap(__float_as_uint(v), __float_as_uint(v), false, false); return fmaxf(__uint_as_float(r[0]), __uint_as_float(r[1])); }
#define DPP_F(v, ctrl) __int_as_float(__builtin_amdgcn_update_dpp(0, __float_as_int(v), (ctrl), 0xf, 0xf, true))
__device__ __forceinline__ float wave_sum(float v) {
    v += DPP_F(v, 0xB1); v += DPP_F(v, 0x4E); v += DPP_F(v, 0x141); v += DPP_F(v, 0x140);
    v += xor16_f(v); return sum_xor32(v);
}
__device__ __forceinline__ float wave_max(float v) {
    v = fmaxf(v, DPP_F(v, 0xB1)); v = fmaxf(v, DPP_F(v, 0x4E)); v = fmaxf(v, DPP_F(v, 0x141)); v = fmaxf(v, DPP_F(v, 0x140));
    v = fmaxf(v, xor16_f(v)); return max_xor32(v);
}
namespace pg8 {
#define PG8_LAS __attribute__((address_space(3)))
typedef unsigned short bf16_t;
typedef short bf16x8 __attribute__((ext_vector_type(8)));
typedef float f32x4 __attribute__((ext_vector_type(4)));
typedef unsigned u32x4 __attribute__((ext_vector_type(4)));
constexpr int BM = 256, BK = 64, HALF = 128, HTB = HALF * BK * 2  , STAGE_BYTES = 8 * HTB, NXCD = 8, WGM = 8;

__host__ __device__ __forceinline__ int lds_byte(int r, int c) { const int st = (r >> 4) * 2 + (c >> 5), rr = r & 15, cc = c & 31, ob = rr * 64 + cc * 2; return st * 1024 + (ob ^ (((ob >> 9) & 1) << 5)); }
__host__ __device__ __forceinline__ void stage_rc(int b, int& R, int& C) { const int st = b / 1024, sb = b % 1024, swz = sb ^ (((sb >> 9) & 1) << 5); R = (st >> 1) * 16 + swz / 64; C = (st & 1) * 32 + (swz % 64) / 2; }
__host__ __device__ __forceinline__ int perm32(int rho) { const int n = rho >> 4, i = rho & 15; return 8 * (i >> 2) + 4 * n + (i & 3); }

struct Unit { int pm, pn; };
struct Gemm { const bf16_t* A; const bf16_t* Bt; int M, N, K; };

__device__ __forceinline__ void map_linear(int wgid, int nM, int nN, Unit& u) {
    const int nwg = nM * nN;
    { const int q = nwg / NXCD, r = nwg % NXCD, xcd = wgid % NXCD, off = wgid / NXCD; wgid = (xcd < r ? xcd * (q + 1) : r * (q + 1) + (xcd - r) * q) + off; }
    const int nig = WGM * nN, gid = wgid / nig, fm = gid * WGM, gsz = (nM - fm) < WGM ? (nM - fm) : WGM;
    u.pm = fm + ((wgid % nig) % gsz); u.pn = (wgid % nig) / gsz;
}
struct GridOrder {
    int nM, nN, extra, extra_pm0, extra_pn, G, c;
    __device__ __forceinline__ bool next(int i, Unit& u) const {
        const long L = (long)i * G + c; const int nwg = nM * nN;
        if (L < nwg) { map_linear((int)L, nM, nN, u); return true; }
        if (L < nwg + extra) { u.pm = extra_pm0 + (int)(L - nwg); u.pn = extra_pn; return true; }
        return false;
    }
    __device__ __forceinline__ void a_ready(const Unit&) const {}
    __device__ __forceinline__ void done(const Unit&) const {}
};

__device__ __forceinline__ unsigned cvt_pk_bf16(float lo, float hi) { unsigned r; asm volatile("v_cvt_pk_bf16_f32 %0, %1, %2" : "=v"(r) : "v"(lo), "v"(hi)); return r; }
__device__ __forceinline__ float silu_f(float x) { return x * __builtin_amdgcn_rcpf(1.0f + __expf(-x)); }
typedef unsigned u32x2 __attribute__((ext_vector_type(2)));
constexpr int NINW = 2816, KVP = 128, KVROWS = 2304;
constexpr float QSCALE = 0.125f * 1.4426950408889634f;

struct EpiIn {
    static constexpr bool PERM = false, AFTER_DRAIN = false;
    bf16_t* PX; bf16_t* KALL; bf16_t* VALL; bf16_t* HYT; bf16_t* HYTC; const float* qn; const float* kn; const float* rope; PG8_LAS unsigned char* stg0;
    __device__ __forceinline__ void operator()(const f32x4 (&acc)[2][2][4][2], const Unit& u, int wr, int wc, int fr, int fq) const {
        asm volatile("" : "+v"(fr), "+v"(fq));
        const int pn = u.pn; const bool isctx = u.pm >= 256;
        const int rowt = u.pm * 256 + wr * 64 + fr;
        if (pn >= 6 && pn <= 8) {
            const bool isv = (pn == 8) && (wc >= 2); const bool isq = pn != 8;
            const float* gw = isq ? qn : kn;
            const int ax = fq >> 1, d0 = 32 * ax + 8 * (fq & 1);
            f32x4 g[2][2];
#pragma unroll
            for (int bj = 0; bj < 2; ++bj)
#pragma unroll
                for (int n = 0; n < 2; ++n) g[bj][n] = *(const f32x4*)(gw + d0 + 16 * bj + 4 * n);
            const int bb = isctx ? (u.pm - 256) : (u.pm >> 3);
#pragma unroll
            for (int ai = 0; ai < 2; ++ai)
#pragma unroll
                for (int m = 0; m < 4; ++m) {
                    const int row = rowt + 128 * ai + 16 * m;
                    const int t = isctx ? (row & 255) : (row & 2047);
                    f32x4 x[2][2];
#pragma unroll
                    for (int bj = 0; bj < 2; ++bj)
#pragma unroll
                        for (int n = 0; n < 2; ++n) x[bj][n] = acc[ai][bj][m][n];
                    if (!isv) {
                        float ss = 0.f;
#pragma unroll
                        for (int bj = 0; bj < 2; ++bj)
#pragma unroll
                            for (int n = 0; n < 2; ++n) ss += (x[bj][n][0] * x[bj][n][0] + x[bj][n][1] * x[bj][n][1]) + (x[bj][n][2] * x[bj][n][2] + x[bj][n][3] * x[bj][n][3]);
                        ss += xor16_f(ss); ss = sum_xor32(ss);
                        const float rs = 1.0f / sqrtf(ss * (1.0f / 64.0f) + 1e-6f) * (isq ? QSCALE : 1.0f);
#pragma unroll
                        for (int bj = 0; bj < 2; ++bj)
#pragma unroll
                            for (int n = 0; n < 2; ++n) x[bj][n] = x[bj][n] * rs * g[bj][n];
                        if (!isctx) {
                            const int pos = ax == 0 ? (t >> 6) : (t & 63);
                            const float* rp = rope + (pos * 16 + 8 * (fq & 1)) * 2;
#pragma unroll
                            for (int n = 0; n < 2; ++n) { const f32x4 cs0 = *(const f32x4*)(rp + 8 * n), cs1 = *(const f32x4*)(rp + 8 * n + 4);
                                const float cc[4] = {cs0[0], cs0[2], cs1[0], cs1[2]}, sn[4] = {cs0[1], cs0[3], cs1[1], cs1[3]};
#pragma unroll
                                for (int e = 0; e < 4; ++e) { const float a = x[0][n][e], b = x[1][n][e]; x[0][n][e] = a * cc[e] - b * sn[e]; x[1][n][e] = a * sn[e] + b * cc[e]; } }
                        }
                    }
                    bf16_t* dst;
                    if (isq) dst = PX + (size_t)row * NINW + 1536 + 256 * (pn - 6) + 64 * wc + d0;
                    else { const int tk = isctx ? (2048 + t) : t; dst = (isv ? VALL : KALL) + ((size_t)bb * KVROWS + tk) * KVP + 64 * (wc & 1) + d0; }
#pragma unroll
                    for (int bj = 0; bj < 2; ++bj) { u32x4 w; w.x = cvt_pk_bf16(x[bj][0][0], x[bj][0][1]); w.y = cvt_pk_bf16(x[bj][0][2], x[bj][0][3]); w.z = cvt_pk_bf16(x[bj][1][0], x[bj][1][1]); w.w = cvt_pk_bf16(x[bj][1][2], x[bj][1][3]);
                        *(u32x4*)(dst + 16 * bj) = w; }
                    asm volatile("" ::: "memory");
                }
        } else {
            const bool dosilu = false;
            const bool dotr = (pn == 3) || (pn == 4);
            const int wid = wr * 4 + wc;
            PG8_LAS unsigned char* stg = stg0 + wid * 2304;
            bf16_t* hyt; int Lq, s0, bb;
            if (isctx) { hyt = HYTC + (size_t)(pn - 3) * 256 * 32 * 256; Lq = 256; s0 = 0; bb = u.pm - 256; }
            else { hyt = HYT + (size_t)(pn - 3) * 256 * 32 * 2048; Lq = 2048; s0 = (u.pm & 7) * 256; bb = u.pm >> 3; }
#pragma unroll
            for (int ai = 0; ai < 2; ++ai)
#pragma unroll
                for (int bj = 0; bj < 2; ++bj) {
                    f32x4 v[4][2];
#pragma unroll
                    for (int m = 0; m < 4; ++m)
#pragma unroll
                        for (int n = 0; n < 2; ++n) { v[m][n] = acc[ai][bj][m][n];
                            if (dosilu) { v[m][n][0] = silu_f(v[m][n][0]); v[m][n][1] = silu_f(v[m][n][1]); v[m][n][2] = silu_f(v[m][n][2]); v[m][n][3] = silu_f(v[m][n][3]); } }
                    if (!dotr)
#pragma unroll
                    for (int m = 0; m < 4; ++m) { const int row = rowt + 128 * ai + 16 * m;
                        u32x4 w; w.x = cvt_pk_bf16(v[m][0][0], v[m][0][1]); w.y = cvt_pk_bf16(v[m][0][2], v[m][0][3]); w.z = cvt_pk_bf16(v[m][1][0], v[m][1][1]); w.w = cvt_pk_bf16(v[m][1][2], v[m][1][3]);
                        *(u32x4*)(PX + (size_t)row * NINW + 256 * pn + 128 * bj + 32 * wc + 8 * fq) = w; }
                    if (dotr) {
                        const int lane = fq * 16 + fr;
#pragma unroll
                        for (int n = 0; n < 2; ++n) {
#pragma unroll
                            for (int m = 0; m < 4; ++m)
#pragma unroll
                                for (int e = 0; e < 4; ++e) { const unsigned bits = cvt_pk_bf16(v[m][n][e], 0.f); *(PG8_LAS unsigned short*)(stg + (4 * fq + e) * 144 + (16 * m + fr) * 2) = (unsigned short)bits; }
#pragma unroll
                            for (int k = 0; k < 2; ++k) { const int piece = lane + 64 * k, cs = piece >> 3, chunk = piece & 7;
                                const u32x4 w = *(const PG8_LAS u32x4*)(stg + cs * 144 + chunk * 16);
                                const int ch = 128 * bj + 32 * wc + 8 * (cs >> 2) + 4 * n + (cs & 3);
                                *(u32x4*)(hyt + ((size_t)ch * 32 + bb) * Lq + s0 + 128 * ai + 64 * wr + 8 * chunk) = w; }
                        }
                    }
                    asm volatile("" ::: "memory");
                }
        }
    }
};

constexpr float DN_ALPHA = 1.4142135623730951f;
struct EpiOut {
    static constexpr bool PERM = true, AFTER_DRAIN = false;
    bf16_t* GY; const float* gate;
    __device__ __forceinline__ void operator()(const f32x4 (&acc)[2][2][4][2], const Unit& u, int wr, int wc, int fr, int fq) const {
        asm volatile("" : "+v"(fr), "+v"(fq));
        const bool isctx = u.pm >= 256; const int bb = isctx ? 32 : (u.pm >> 3);
        const int rowt = u.pm * 256 + wr * 64 + fr, col0 = u.pn * 256 + wc * 32 + 8 * fq;
        f32x4 gv[2][2];
#pragma unroll
        for (int bj = 0; bj < 2; ++bj)
#pragma unroll
            for (int n = 0; n < 2; ++n) gv[bj][n] = *(const f32x4*)(gate + (size_t)bb * 3072 + 2048 + col0 + 128 * bj + 4 * n);
#pragma unroll
        for (int ai = 0; ai < 2; ++ai)
#pragma unroll
            for (int m = 0; m < 4; ++m) { bf16_t* rowp = GY + (size_t)(rowt + 128 * ai + 16 * m) * 1024 + col0;
#pragma unroll
                for (int bj = 0; bj < 2; ++bj) { const f32x4 v0 = acc[ai][bj][m][0] * gv[bj][0], v1 = acc[ai][bj][m][1] * gv[bj][1];
                    u32x4 w; w.x = cvt_pk_bf16(v0[0], v0[1]); w.y = cvt_pk_bf16(v0[2], v0[3]); w.z = cvt_pk_bf16(v1[0], v1[1]); w.w = cvt_pk_bf16(v1[2], v1[3]);
                    *(u32x4*)(rowp + 128 * bj) = w; } }
    }
};


struct EpiDummy {
    static constexpr bool PERM = true, AFTER_DRAIN = false;
    bf16_t* O; int ldc;
    __device__ __forceinline__ void operator()(const f32x4 (&acc)[2][2][4][2], const Unit& u, int wr, int wc, int fr, int fq) const {
        asm volatile("" : "+v"(fr), "+v"(fq));
        const int row0 = u.pm * 256 + wr * 64 + fr, col0 = u.pn * 256 + wc * 32 + 8 * fq;
#pragma unroll
        for (int ai = 0; ai < 2; ++ai)
#pragma unroll
            for (int m = 0; m < 4; ++m) { bf16_t* rowp = O + (size_t)(row0 + ai * 128 + m * 16) * ldc + col0;
#pragma unroll
                for (int bj = 0; bj < 2; ++bj) { const f32x4 v0 = acc[ai][bj][m][0], v1 = acc[ai][bj][m][1];
                    u32x4 w; w.x = cvt_pk_bf16(v0[0], v0[1]); w.y = cvt_pk_bf16(v0[2], v0[3]); w.z = cvt_pk_bf16(v1[0], v1[1]); w.w = cvt_pk_bf16(v1[2], v1[3]);
#ifdef DUMMY_NOSTORE
                    asm volatile("" :: "v"(w.x), "v"(w.y), "v"(w.z), "v"(w.w)); (void)rowp; } }
#else
                    *(u32x4*)(rowp + 128 * bj) = w; } }
#endif
    }
};
template <class Epi, class Sched, bool ALIGN_EPI = false, bool SP2 = false>
__device__ __forceinline__ void gemm_phase(PG8_LAS unsigned char* lds, const Gemm g, const Sched& S, const Epi& E, int wave0) {
    int wid_ = wave0; asm volatile("" : "+s"(wid_));
    const int lane = fresh_lane(), wid = wid_, tid = wid * 64 + lane, wr = wid >> 2, wc = wid & 3, fr = lane & 15, fq = lane >> 4;
    const int K = g.K, nt = K / BK;
    unsigned voffA[2], voffB[2];
#pragma unroll
    for (int i = 0; i < 2; ++i) { int R, C; stage_rc(tid * 16 + i * 8192, R, C); const int Rb = Epi::PERM ? ((R & ~31) + perm32(R & 31)) : R;
        voffA[i] = (unsigned)(R * K + C) * 2u; voffB[i] = (unsigned)(Rb * K + C) * 2u; }
    const size_t kstep = (size_t)(BK * 2);
    const size_t hstep = (size_t)HALF * K * 2;
    const size_t tstep = 2 * hstep;
    const unsigned ldsw = (unsigned)wid * 1024u;
    const int aoff = lds_byte(wr * 64 + fr, fq * 8), boff = lds_byte(wc * 32 + fr, fq * 8);
#define PG8_SA(b, h) (((b) * 2 + (h)) * HTB)
#define PG8_SB(b, h) ((4 + (b) * 2 + (h)) * HTB)
#define PG8_STAGE(bufoff, gbase, voff) do { _Pragma("unroll") for (int _i = 0; _i < 2; ++_i) \
        __builtin_amdgcn_global_load_lds((const unsigned*)((const char*)(gbase) + (voff)[_i]), (PG8_LAS unsigned*)(lds + (bufoff) + ldsw + _i * 8192), 16, 0, 0); } while (0)
#define PG8_LDA(dst, b, h) do { _Pragma("unroll") for (int m = 0; m < 4; ++m) _Pragma("unroll") for (int k = 0; k < 2; ++k) dst[m][k] = *(const PG8_LAS bf16x8*)(lds + PG8_SA(b, h) + aoff + m * 2048 + k * 1024); } while (0)
#define PG8_LDB(dst, b, h) do { _Pragma("unroll") for (int n = 0; n < 2; ++n) _Pragma("unroll") for (int k = 0; k < 2; ++k) dst[n][k] = *(const PG8_LAS bf16x8*)(lds + PG8_SB(b, h) + boff + n * 2048 + k * 1024); } while (0)
#define PG8_MMA(ai, bj, At, Bt) do { __builtin_amdgcn_s_setprio(1); _Pragma("unroll") for (int m = 0; m < 4; ++m) _Pragma("unroll") for (int n = 0; n < 2; ++n) _Pragma("unroll") for (int k = 0; k < 2; ++k) \
        acc[ai][bj][m][n] = __builtin_amdgcn_mfma_f32_16x16x32_bf16(Bt[n][k], At[m][k], acc[ai][bj][m][n], 0, 0, 0); __builtin_amdgcn_s_setprio(0); } while (0)
#define PG8_WAIT_V(n) asm volatile("s_waitcnt vmcnt(" #n ")" ::: "memory")
#define PG8_WAIT_L(n) asm volatile("s_waitcnt lgkmcnt(" #n ")" ::: "memory")
#define PG8_BAR __builtin_amdgcn_s_barrier()
#define PG8_SCHED __builtin_amdgcn_sched_barrier(0)
    Unit cur, nxt; int ui = 0;
    if (!S.next(0, cur)) return;
    f32x4 acc[2][2][4][2];
#pragma unroll
    for (int a = 0; a < 2; ++a)
#pragma unroll
        for (int b = 0; b < 2; ++b)
#pragma unroll
            for (int m = 0; m < 4; ++m)
#pragma unroll
                for (int n = 0; n < 2; ++n) acc[a][b][m][n] = (f32x4){0.f, 0.f, 0.f, 0.f};
    bf16x8 At[4][2], B0[2][2], B1[2][2];
    const char* cA = (const char*)g.A + (size_t)cur.pm * tstep; const char* cB = (const char*)g.Bt + (size_t)cur.pn * tstep;
    S.a_ready(cur);
    if constexpr (SP2) {
        PG8_STAGE(PG8_SB(0, 0), cB, voffB); PG8_STAGE(PG8_SB(0, 1), cB + hstep, voffB); PG8_STAGE(PG8_SA(0, 0), cA, voffA); PG8_STAGE(PG8_SA(0, 1), cA + hstep, voffA);
        if (wr == 1) PG8_BAR;
        PG8_WAIT_V(2); PG8_BAR;
        PG8_STAGE(PG8_SB(1, 0), cB + kstep, voffB); PG8_STAGE(PG8_SA(1, 0), cA + kstep, voffA); PG8_STAGE(PG8_SB(1, 1), cB + hstep + kstep, voffB);
        PG8_WAIT_V(6); PG8_BAR;
    } else {
        PG8_STAGE(PG8_SB(0, 0), cB, voffB); PG8_STAGE(PG8_SA(0, 0), cA, voffA); PG8_STAGE(PG8_SB(0, 1), cB + hstep, voffB); PG8_STAGE(PG8_SA(0, 1), cA + hstep, voffA);
        if (wr == 1) PG8_BAR;
        PG8_WAIT_V(4); PG8_BAR;
        PG8_STAGE(PG8_SB(1, 0), cB + kstep, voffB); PG8_STAGE(PG8_SA(1, 0), cA + kstep, voffA); PG8_STAGE(PG8_SB(1, 1), cB + hstep + kstep, voffB);
        PG8_WAIT_V(6); PG8_BAR;
    }
    for (;;) {
        const bool has_next = S.next(ui + 1, nxt);
        const char* nA = has_next ? (const char*)g.A + (size_t)nxt.pm * tstep : cA; const char* nB = has_next ? (const char*)g.Bt + (size_t)nxt.pn * tstep : cB;
        for (int t = 0; t < nt; t += 2) {
            const bool last = (t == nt - 2);
            const char* a1 = cA + (size_t)(t + 1) * kstep;
            const char* a2 = last ? nA : cA + (size_t)(t + 2) * kstep; const char* b2 = last ? nB : cB + (size_t)(t + 2) * kstep;
            const char* a3 = a2 + kstep; const char* b3 = b2 + kstep;
            if (last && has_next) S.a_ready(nxt);
            if constexpr (SP2) {
            PG8_LDB(B0, 0, 0); PG8_LDB(B1, 0, 1); PG8_SCHED; PG8_LDA(At, 0, 0); PG8_STAGE(PG8_SA(1, 1), a1 + hstep, voffA);
            PG8_WAIT_V(8); PG8_WAIT_L(0); PG8_BAR; PG8_MMA(0, 0, At, B0); PG8_MMA(0, 1, At, B1); PG8_BAR; PG8_SCHED;
            PG8_LDA(At, 0, 1); PG8_STAGE(PG8_SB(0, 0), b2, voffB); PG8_STAGE(PG8_SB(0, 1), b2 + hstep, voffB); PG8_STAGE(PG8_SA(0, 0), a2, voffA);
            PG8_WAIT_V(8); PG8_WAIT_L(0); PG8_BAR; PG8_MMA(1, 0, At, B0); PG8_MMA(1, 1, At, B1); PG8_BAR; PG8_SCHED;
            PG8_LDB(B0, 1, 0); PG8_LDB(B1, 1, 1); PG8_SCHED; PG8_LDA(At, 1, 0); PG8_STAGE(PG8_SA(0, 1), a2 + hstep, voffA);
            PG8_WAIT_V(8); PG8_WAIT_L(0); PG8_BAR; PG8_MMA(0, 0, At, B0); PG8_MMA(0, 1, At, B1); PG8_BAR; PG8_SCHED;
            PG8_LDA(At, 1, 1); PG8_STAGE(PG8_SB(1, 0), b3, voffB); PG8_STAGE(PG8_SB(1, 1), b3 + hstep, voffB); PG8_STAGE(PG8_SA(1, 0), a3, voffA);
            PG8_WAIT_V(8); PG8_WAIT_L(0); PG8_BAR; PG8_MMA(1, 0, At, B0); PG8_MMA(1, 1, At, B1); PG8_BAR; PG8_SCHED;
            } else {
            PG8_LDB(B0, 0, 0); PG8_SCHED; PG8_LDA(At, 0, 0); PG8_STAGE(PG8_SA(1, 1), a1 + hstep, voffA);
            PG8_WAIT_L(8); PG8_BAR; PG8_WAIT_L(0); PG8_MMA(0, 0, At, B0); PG8_BAR; PG8_SCHED;
            PG8_LDB(B1, 0, 1); PG8_STAGE(PG8_SB(0, 0), b2, voffB);
            PG8_BAR; PG8_WAIT_L(0); PG8_MMA(0, 1, At, B1); PG8_BAR;
            PG8_LDA(At, 0, 1); PG8_STAGE(PG8_SA(0, 0), a2, voffA);
            PG8_BAR; PG8_WAIT_L(0); PG8_MMA(1, 0, At, B0); PG8_BAR; PG8_SCHED;
            PG8_STAGE(PG8_SB(0, 1), b2 + hstep, voffB);
            PG8_WAIT_V(6); PG8_BAR; PG8_MMA(1, 1, At, B1); PG8_BAR;
            PG8_LDB(B0, 1, 0); PG8_SCHED; PG8_LDA(At, 1, 0); PG8_STAGE(PG8_SA(0, 1), a2 + hstep, voffA);
            PG8_WAIT_L(8); PG8_BAR; PG8_WAIT_L(0); PG8_MMA(0, 0, At, B0); PG8_BAR; PG8_SCHED;
            PG8_LDB(B1, 1, 1); PG8_STAGE(PG8_SB(1, 0), b3, voffB);
            PG8_BAR; PG8_WAIT_L(0); PG8_MMA(0, 1, At, B1); PG8_BAR;
            PG8_LDA(At, 1, 1); PG8_STAGE(PG8_SA(1, 0), a3, voffA);
            PG8_BAR; PG8_WAIT_L(0); PG8_MMA(1, 0, At, B0); PG8_BAR; PG8_SCHED;
            PG8_STAGE(PG8_SB(1, 1), b3 + hstep, voffB);
            PG8_WAIT_V(6); PG8_BAR; PG8_MMA(1, 1, At, B1); PG8_BAR;
            }
        }
        if constexpr (ALIGN_EPI) { if (wr == 0) PG8_BAR; }
        if constexpr (!Epi::AFTER_DRAIN) { E(acc, cur, wr, wc, fr, fq); S.done(cur); }
        if (!has_next) break;
#pragma unroll
        for (int a = 0; a < 2; ++a)
#pragma unroll
            for (int b = 0; b < 2; ++b)
#pragma unroll
                for (int m = 0; m < 4; ++m)
#pragma unroll
                    for (int n = 0; n < 2; ++n) acc[a][b][m][n] = (f32x4){0.f, 0.f, 0.f, 0.f};
        cur = nxt; cA = nA; cB = nB; ++ui;
        if constexpr (ALIGN_EPI) { if (wr == 1) PG8_BAR; }
    }
    PG8_WAIT_V(0);
    if constexpr (!ALIGN_EPI) { if (wr == 0) PG8_BAR; }
    PG8_BAR;
    if constexpr (Epi::AFTER_DRAIN) { E.fused(acc, cur, wr, wc, fr, fq, lds, wid, lane); S.done(cur); }
#undef PG8_SA
#undef PG8_SB
#undef PG8_STAGE
#undef PG8_LDA
#undef PG8_LDB
#undef PG8_MMA
#undef PG8_WAIT_V
#undef PG8_WAIT_L
#undef PG8_BAR
#undef PG8_SCHED
}
}
#define ATTN_STORE16(p,v) (*(u32x4*)(p)=(v))
namespace attn_body {
using bf16=__hip_bfloat16;
using bf16x8=__attribute__((ext_vector_type(8)))short;
using s16x4=__attribute__((ext_vector_type(4)))short;
using f32x16=__attribute__((ext_vector_type(16)))float;
using u32x4=__attribute__((ext_vector_type(4)))unsigned;
constexpr int D=64;
constexpr int NW=8,QBLK=32,QB=QBLK*NW,KVBLK=64;
__device__ __forceinline__ int crow(int r,int hi){return (r&3)+8*(r>>2)+4*hi;}
#define SBAR() __builtin_amdgcn_sched_barrier(0)

constexpr int NSLOT=3, SLOTB=8192;
constexpr int LDS_K=0, LDS_V=NSLOT*SLOTB, LDS_WS=2*NSLOT*SLOTB, LDS_OST=LDS_WS+NW*64*4, LDS_BYTES=LDS_OST+NW*4096;
constexpr float C2=0.125f*1.4426950408889634f;
__device__ __forceinline__ void glds16(const void*gsrc,unsigned lds_dst){unsigned keep;
  asm volatile("s_mov_b32 %0, m0\n\ts_mov_b32 m0, %2\n\ts_nop 0\n\tglobal_load_lds_dwordx4 %1, off\n\ts_mov_b32 m0, %0":"=&s"(keep):"v"(gsrc),"s"(lds_dst):"memory");}
__device__ __forceinline__ float max3f(float a,float b,float c){float r;asm("v_max3_f32 %0, %1, %2, %3":"=v"(r):"v"(a),"v"(b),"v"(c));return r;}
__device__ __forceinline__ float max2f(float a,float b){float r;asm("v_max_f32_e32 %0, %1, %2":"=v"(r):"v"(a),"v"(b));return r;}
__device__ __forceinline__ float fadd_s(float a,float b){float r;asm("v_add_f32_e32 %0, %1, %2":"=v"(r):"v"(a),"v"(b));return r;}
__device__ __forceinline__ float fsub_s(float a,float b){float r;asm("v_sub_f32_e32 %0, %1, %2":"=v"(r):"v"(a),"v"(b));return r;}
typedef float f32x2_t __attribute__((ext_vector_type(2))); typedef __bf16 bf16x2_t __attribute__((ext_vector_type(2)));
__device__ __forceinline__ unsigned cvtpk_s(float lo,float hi){f32x2_t v={lo,hi};bf16x2_t b=__builtin_convertvector(v,bf16x2_t);return __builtin_bit_cast(unsigned,b);}
#define WAIT_BAR(N) asm volatile("s_waitcnt vmcnt(" #N ") lgkmcnt(0)\n\ts_barrier":::"memory")

__device__ __forceinline__ void qkt(f32x16&p0,f32x16&p1,const char*Kslot,const bf16x8*qr,const f32x16&negm,int r32,int hi){
  const char*kb=Kslot+hi*1024+r32*16;
  #pragma unroll
  for(int d0=0;d0<4;++d0){
    const bf16x8 b0=*reinterpret_cast<const bf16x8*>(kb+d0*2048);
    const bf16x8 b1=*reinterpret_cast<const bf16x8*>(kb+d0*2048+512);
    if(d0==0){p0=__builtin_amdgcn_mfma_f32_32x32x16_bf16(b0,qr[0],negm,0,0,0);p1=__builtin_amdgcn_mfma_f32_32x32x16_bf16(b1,qr[0],negm,0,0,0);}
    else{p0=__builtin_amdgcn_mfma_f32_32x32x16_bf16(b0,qr[d0],p0,0,0,0);p1=__builtin_amdgcn_mfma_f32_32x32x16_bf16(b1,qr[d0],p1,0,0,0);}}
}
typedef __attribute__((address_space(3))) const char* lds_cptr;
typedef short v4i16_t __attribute__((ext_vector_type(4)));
__device__ __forceinline__ void kload8(bf16x8*kf,lds_cptr kp){
  kf[0]=*(const __attribute__((address_space(3))) bf16x8*)(kp);      kf[1]=*(const __attribute__((address_space(3))) bf16x8*)(kp+512);
  kf[2]=*(const __attribute__((address_space(3))) bf16x8*)(kp+2048); kf[3]=*(const __attribute__((address_space(3))) bf16x8*)(kp+2560);
  kf[4]=*(const __attribute__((address_space(3))) bf16x8*)(kp+4096); kf[5]=*(const __attribute__((address_space(3))) bf16x8*)(kp+4608);
  kf[6]=*(const __attribute__((address_space(3))) bf16x8*)(kp+6144); kf[7]=*(const __attribute__((address_space(3))) bf16x8*)(kp+6656);
}
__device__ __forceinline__ void kload2(bf16x8*kf,lds_cptr kp,int j){ kf[2*j]=*(const __attribute__((address_space(3))) bf16x8*)(kp+j*2048); kf[2*j+1]=*(const __attribute__((address_space(3))) bf16x8*)(kp+j*2048+512); }
__device__ __forceinline__ s16x4 vtr(lds_cptr p){ return __builtin_bit_cast(s16x4,__builtin_amdgcn_ds_read_tr16_b64_v4i16((__attribute__((address_space(3))) v4i16_t*)p)); }
__device__ __forceinline__ float rowmax(const f32x16&p0,const f32x16&p1){
  float a=max3f(p0[0],p0[1],p1[0]),b=max3f(p0[2],p0[3],p1[1]);a=max3f(a,p1[2],p1[3]);
  #pragma unroll
  for(int r=4;r<16;r+=4){a=max3f(a,p0[r],p0[r+1]);b=max3f(b,p0[r+2],p0[r+3]);a=max3f(a,p1[r],p1[r+1]);b=max3f(b,p1[r+2],p1[r+3]);}
  const float m=max2f(a,b);
  auto rr=__builtin_amdgcn_permlane32_swap(__float_as_uint(m),__float_as_uint(m),false,false);
  return max2f(__uint_as_float(rr[0]),__uint_as_float(rr[1]));
}
__device__ __forceinline__ void pv(f32x16*o,int vb,bf16x8 pa0,bf16x8 pa1,bf16x8 pa2,bf16x8 pa3){
  #pragma unroll
  for(int d0=0;d0<2;++d0){s16x4 lo[4],hi[4];
    #pragma unroll
    for(int ks=0;ks<4;++ks){
      asm volatile("ds_read_b64_tr_b16 %0,%1 offset:%c2":"=&v"(lo[ks]):"v"(vb),"i"(d0*4096+ks*1024):"memory");
      asm volatile("ds_read_b64_tr_b16 %0,%1 offset:%c2":"=&v"(hi[ks]):"v"(vb),"i"(d0*4096+ks*1024+512):"memory");}
    asm volatile("s_waitcnt lgkmcnt(0)":::"memory");SBAR();
    #define PK(k) (bf16x8){lo[k][0],lo[k][1],lo[k][2],lo[k][3],hi[k][0],hi[k][1],hi[k][2],hi[k][3]}
    o[d0]=__builtin_amdgcn_mfma_f32_32x32x16_bf16(pa0,PK(0),o[d0],0,0,0);
    o[d0]=__builtin_amdgcn_mfma_f32_32x32x16_bf16(pa1,PK(1),o[d0],0,0,0);
    o[d0]=__builtin_amdgcn_mfma_f32_32x32x16_bf16(pa2,PK(2),o[d0],0,0,0);
    o[d0]=__builtin_amdgcn_mfma_f32_32x32x16_bf16(pa3,PK(3),o[d0],0,0,0);
    #undef PK
  }
}


template<int THRL,bool NOMAX> __device__ __forceinline__ void attn_unit(const bf16*Qw0,int qpitch,const bf16*__restrict__ Kh,const bf16*__restrict__ Vh,int kvpitch,int NT,bf16*Ow0,int opitch,const bf16*Gw0,int gpitch,char*shm,int wave0,const bf16*nKh,const bf16*nVh,bool pre_issued){
  const int lane=fresh_lane(),r32=lane&31,hi=lane>>5,wid=wave0,tid=wid*64+lane;
  const bf16*Qw=Qw0+(long)(wid*QBLK)*qpitch;
  const unsigned lds0=(unsigned)(uintptr_t)shm;
  float*wsf=(float*)(shm+LDS_WS)+wid*64;
  const bf16*ksrc=Kh+(long)lane*kvpitch+wid*8;
  const bf16*vsrc=Vh+(long)(16*(wid&3)+(lane>>2))*kvpitch+(wid>>2)*32+(lane&3)*8;
  const unsigned kdst=lds0+LDS_K+wid*1024, vdst=lds0+LDS_V+wid*1024;
  #define DMA_K(t,slot) glds16(ksrc+(long)(t)*KVBLK*kvpitch,(unsigned)__builtin_amdgcn_readfirstlane(kdst+(slot)))
  #define DMA_V(t,slot) glds16(vsrc+(long)(t)*KVBLK*kvpitch,(unsigned)__builtin_amdgcn_readfirstlane(vdst+(slot)))
  const int vb0=(int)(lds0+LDS_V)+((lane>>4)&1)*32+(lane&3)*8+(4*hi+((lane&15)>>2))*64;
  const char*Kbase=shm+LDS_K; bf16x8 kf[8];
  const lds_cptr shm3=(lds_cptr)shm; const lds_cptr kp0=shm3+LDS_K+hi*1024+r32*16; const lds_cptr vp0=shm3+LDS_V+((lane>>4)&1)*32+(lane&3)*8+(4*hi+((lane&15)>>2))*64;
  if(!pre_issued){DMA_K(0,0);DMA_V(0,0);DMA_K(1,SLOTB);}
  bf16x8 qr[4];
  #pragma unroll
  for(int d0=0;d0<4;++d0)qr[d0]=*reinterpret_cast<const bf16x8*>(&Qw[(long)r32*qpitch+d0*16+hi*8]);
  float mhat=0.f,l_reg=0.f;f32x16 o[2];o[0]=f32x16{};o[1]=f32x16{};f32x16 negm=f32x16{};asm volatile("":"+v"(negm));
  #define CMASK(P0,P1,t) do{}while(0)
  bool resc=false;
  #define START(P0,P1) do{ resc=false; \
    if(!NOMAX){ const float rm=rowmax(P0,P1); const float dl=rm; mhat=fadd_s(mhat,dl); \
      _Pragma("unroll") for(int r=0;r<16;++r){P0[r]=fsub_s(P0[r],dl);P1[r]=fsub_s(P1[r],dl);} \
      _Pragma("unroll") for(int r=0;r<16;++r)negm[r]=-mhat; asm volatile("":"+v"(negm)); } \
    _Pragma("unroll") for(int r=0;r<16;++r)P0[r]=__builtin_amdgcn_exp2f(P0[r]); }while(0)
  #define RESC() do{ if(resc){ asm volatile("s_waitcnt lgkmcnt(0)":::"memory"); \
      _Pragma("unroll") for(int d_=0;d_<2;++d_) _Pragma("unroll") for(int r=0;r<16;++r)o[d_][r]*=wsf[crow(r,hi)]; } }while(0)
  f32x16 pA0,pA1,pB0,pB1;
  int sl_prev=0,sl_cur=0,sl_next=SLOTB;
  #define ROT() do{sl_prev=sl_cur;sl_cur=sl_next;sl_next=(sl_next==(NSLOT-1)*SLOTB)?0:sl_next+SLOTB;}while(0)
  if(!pre_issued){DMA_K(2,2*SLOTB);}
  WAIT_BAR(3);
  qkt(pA0,pA1,Kbase,qr,negm,r32,hi);asm volatile("s_nop 15\n\ts_nop 7":"+v"(pA0),"+v"(pA1));CMASK(pA0,pA1,0);
  START(pA0,pA1);
  _Pragma("unroll") for(int r=0;r<16;++r)pA1[r]=__builtin_amdgcn_exp2f(pA1[r]);
  WAIT_BAR(0);
  DMA_K(3,0);DMA_V(1,SLOTB);
  ROT();
  kload8(kf,kp0+sl_cur);
  WAIT_BAR(2);
  s16x4 vlo[8],vhi[8]; u32x4 pw0,pw1,pw2,pw3;
  #define PKW(P,B) cvtpk_s(P[B],P[B+1])
  #define PAF(k) __builtin_bit_cast(bf16x8,pw##k)
  #define VFR(i) (bf16x8){vlo[i][0],vlo[i][1],vlo[i][2],vlo[i][3],vhi[i][0],vhi[i][1],vhi[i][2],vhi[i][3]}
  #define PIN(x) asm volatile("":"+v"(x))
  #define MX3(a,b,c) __builtin_fmaxf(__builtin_fmaxf((a),(b)),(c))
  #define GAPA(MF,A0,A1,A2,A3,W0,W1,PW) do{ MF; sacc+=A0; sacc+=A1; sacc+=A2; sacc+=A3; PIN(sacc); W0; W1; PIN(PW); SBAR(); }while(0)
  #define EX(v) __builtin_amdgcn_exp2f(v)
  #define GAPB(MF,X,B) do{ MF; X[B]=EX(X[B]); X[B+1]=EX(X[B+1]); X[B+2]=EX(X[B+2]); X[B+3]=EX(X[B+3]); PIN(X); SBAR(); }while(0)
  #define VRD(i) do{ vlo[i]=vtr(vp_+(((i)>>2)*4096+((i)&3)*1024)); vhi[i]=vtr(vp_+(((i)>>2)*4096+((i)&3)*1024+512)); }while(0)
  #define KRD(G,j) do{ if(G){ kload2(kf,kp0+sl_next,j); SBAR(); } }while(0)
  #define STEP(C0,C1,P0,P1,t,GK,GV,GL) do{ SBAR(); \
    const lds_cptr vp_=vp0+sl_prev; \
    VRD(0); SBAR(); float sacc=(P0[0]+P0[1]); \
    GAPA(C0=__builtin_amdgcn_mfma_f32_32x32x16_bf16(kf[0],qr[0],negm,0,0,0), P0[2],P0[3],P0[4],P0[5],     pw0[0]=PKW(P0,0), pw0[1]=PKW(P0,2), pw0); \
    VRD(4); SBAR(); GAPA(C1=__builtin_amdgcn_mfma_f32_32x32x16_bf16(kf[1],qr[0],negm,0,0,0), P0[6],P0[7],P0[8],P0[9],     pw0[2]=PKW(P0,4), pw0[3]=PKW(P0,6), pw0); \
    VRD(1); SBAR(); GAPA(C0=__builtin_amdgcn_mfma_f32_32x32x16_bf16(kf[2],qr[1],C0,0,0,0),   P0[10],P0[11],P0[12],P0[13], pw1[0]=PKW(P0,8), pw1[1]=PKW(P0,10), pw1); \
    VRD(5); SBAR(); GAPA(C1=__builtin_amdgcn_mfma_f32_32x32x16_bf16(kf[3],qr[1],C1,0,0,0),   P0[14],P0[15],P1[0],P1[1],   pw1[2]=PKW(P0,12),pw1[3]=PKW(P0,14), pw1); \
    VRD(2); SBAR(); GAPA(C0=__builtin_amdgcn_mfma_f32_32x32x16_bf16(kf[4],qr[2],C0,0,0,0),   P1[2],P1[3],P1[4],P1[5],     pw2[0]=PKW(P1,0), pw2[1]=PKW(P1,2), pw2); \
    VRD(6); SBAR(); GAPA(C1=__builtin_amdgcn_mfma_f32_32x32x16_bf16(kf[5],qr[2],C1,0,0,0),   P1[6],P1[7],P1[8],P1[9],     pw2[2]=PKW(P1,4), pw2[3]=PKW(P1,6), pw2); \
    VRD(3); SBAR(); GAPA(C0=__builtin_amdgcn_mfma_f32_32x32x16_bf16(kf[6],qr[3],C0,0,0,0),   P1[10],P1[11],P1[12],P1[13], pw3[0]=PKW(P1,8), pw3[1]=PKW(P1,10), pw3); \
    VRD(7); SBAR(); GAPA(C1=__builtin_amdgcn_mfma_f32_32x32x16_bf16(kf[7],qr[3],C1,0,0,0),   P1[14],P1[15],0.f,0.f,       pw3[2]=PKW(P1,12),pw3[3]=PKW(P1,14), pw3); \
    l_reg+=sacc; \
    if(GK){DMA_K((t)+3,sl_cur);} if(GV){DMA_V((t)+1,sl_next);} \
    CMASK(C0,C1,t); \
    if(NOMAX){ resc=false; } else { float a=MX3(C0[0],C0[1],C1[0]),b=MX3(C0[2],C0[3],C1[1]); a=MX3(a,C1[2],C1[3]); \
      _Pragma("unroll") for(int r=4;r<16;r+=4){a=MX3(a,C0[r],C0[r+1]);b=MX3(b,C0[r+2],C0[r+3]);a=MX3(a,C1[r],C1[r+1]);b=MX3(b,C1[r+2],C1[r+3]);} \
      float rm=__builtin_fmaxf(a,b); { auto rr=__builtin_amdgcn_permlane32_swap(__float_as_uint(rm),__float_as_uint(rm),false,false); rm=__builtin_fmaxf(__uint_as_float(rr[0]),__uint_as_float(rr[1])); } \
      resc=false; \
      if(__builtin_expect(__any(rm>(float)THRL),0)){ const float dl=__builtin_fmaxf(rm,0.f); mhat+=dl; \
        _Pragma("unroll") for(int r=0;r<16;++r){C0[r]-=dl;C1[r]-=dl;} \
        _Pragma("unroll") for(int r=0;r<16;++r)negm[r]=-mhat; asm volatile("":"+v"(negm)); \
        const float f=__builtin_amdgcn_exp2f(-dl); l_reg*=f; if(hi==0)wsf[r32]=f; resc=true; } } \
    SBAR(); \
    GAPB(o[0]=__builtin_amdgcn_mfma_f32_32x32x16_bf16(PAF(0),VFR(0),o[0],0,0,0), C0,0); \
    GAPB(o[1]=__builtin_amdgcn_mfma_f32_32x32x16_bf16(PAF(0),VFR(4),o[1],0,0,0), C0,4); \
    KRD(GL,0); GAPB(o[0]=__builtin_amdgcn_mfma_f32_32x32x16_bf16(PAF(1),VFR(1),o[0],0,0,0), C0,8); \
    KRD(GL,1); GAPB(o[1]=__builtin_amdgcn_mfma_f32_32x32x16_bf16(PAF(1),VFR(5),o[1],0,0,0), C0,12); \
    KRD(GL,2); GAPB(o[0]=__builtin_amdgcn_mfma_f32_32x32x16_bf16(PAF(2),VFR(2),o[0],0,0,0), C1,0); \
    KRD(GL,3); GAPB(o[1]=__builtin_amdgcn_mfma_f32_32x32x16_bf16(PAF(2),VFR(6),o[1],0,0,0), C1,4); \
    GAPB(o[0]=__builtin_amdgcn_mfma_f32_32x32x16_bf16(PAF(3),VFR(3),o[0],0,0,0), C1,8); \
    GAPB(o[1]=__builtin_amdgcn_mfma_f32_32x32x16_bf16(PAF(3),VFR(7),o[1],0,0,0), C1,12); \
    }while(0)
  int t=1;
  #undef CMASK
  #define CMASK(P0,P1,t) do{}while(0)
  for(;t+5<NT;t+=2){
    STEP(pB0,pB1,pA0,pA1,t,true,true,true);     WAIT_BAR(2); RESC(); ROT();
    STEP(pA0,pA1,pB0,pB1,t+1,true,true,true);   WAIT_BAR(2); RESC(); ROT();
  }
  #undef CMASK
  #define CMASK(P0,P1,t) do{}while(0)
  #define ENDW(tt) do{ if((tt)+3<NT){WAIT_BAR(2);} else if((tt)+2<NT){WAIT_BAR(1);} else {WAIT_BAR(0);} }while(0)
  for(;t+1<NT;t+=2){
    STEP(pB0,pB1,pA0,pA1,t,(t+3<NT),(t+1<NT),(t+1<NT));       ENDW(t);   RESC(); ROT();
    STEP(pA0,pA1,pB0,pB1,t+1,(t+4<NT),(t+2<NT),(t+2<NT));     ENDW(t+1); RESC(); ROT();
  }
  if(nKh){
    const bf16*nks=nKh+(long)lane*kvpitch+wid*8; const bf16*nvs=nVh+(long)(16*(wid&3)+(lane>>2))*kvpitch+(wid>>2)*32+(lane&3)*8;
    glds16(nks,(unsigned)__builtin_amdgcn_readfirstlane(kdst)); glds16(nvs,(unsigned)__builtin_amdgcn_readfirstlane(vdst));
    glds16(nks+(long)KVBLK*kvpitch,(unsigned)__builtin_amdgcn_readfirstlane(kdst+SLOTB)); glds16(nks+(long)2*KVBLK*kvpitch,(unsigned)__builtin_amdgcn_readfirstlane(kdst+2*SLOTB)); }
  STEP(pB0,pB1,pA0,pA1,NT-1,false,false,false); RESC();
  { float sacc=pB0[0]+pB0[1]; _Pragma("unroll") for(int r=2;r<16;++r)sacc+=pB0[r]; _Pragma("unroll") for(int r=0;r<16;++r)sacc+=pB1[r]; l_reg+=sacc;
    pw0=(u32x4){PKW(pB0,0),PKW(pB0,2),PKW(pB0,4),PKW(pB0,6)};pw1=(u32x4){PKW(pB0,8),PKW(pB0,10),PKW(pB0,12),PKW(pB0,14)};pw2=(u32x4){PKW(pB1,0),PKW(pB1,2),PKW(pB1,4),PKW(pB1,6)};pw3=(u32x4){PKW(pB1,8),PKW(pB1,10),PKW(pB1,12),PKW(pB1,14)};
    SBAR(); pv(o,vb0+sl_cur,PAF(0),PAF(1),PAF(2),PAF(3)); }
  #undef PKW
  #undef PAF
  #undef VFR
  #undef PIN
  #undef MX3
  #undef GAPA
  #undef GAPB
  #undef EX
  #undef VRD
  #undef KRD
  #undef STEP
  #undef ENDW
  {auto rr=__builtin_amdgcn_permlane32_swap(__float_as_uint(l_reg),__float_as_uint(l_reg),false,false);l_reg=__uint_as_float(rr[0])+__uint_as_float(rr[1]);}
  if(hi==0)wsf[32+r32]=l_reg;asm volatile("s_waitcnt lgkmcnt(0)":::"memory");
  float rli[16];
  #pragma unroll
  for(int r=0;r<16;++r)rli[r]=__builtin_amdgcn_rcpf(wsf[32+crow(r,hi)]);
  bf16*Ow=Ow0+(long)(wid*QBLK)*opitch; const bf16*Gw=Gw0+(long)(wid*QBLK)*gpitch;
  { bf16*stg=(bf16*)(shm+LDS_OST)+wid*2048;
    u32x4 gv[4];
    #pragma unroll
    for(int i=0;i<4;++i){const int row=i*8+(lane>>3),ch=lane&7; gv[i]=*(const u32x4*)(Gw+(long)row*gpitch+ch*8);}
    #pragma unroll
    for(int r=0;r<16;++r){const int orow=crow(r,hi);
      #pragma unroll
      for(int d0=0;d0<2;++d0)stg[orow*64+d0*32+r32]=__float2bfloat16(o[d0][r]*rli[r]);}
    asm volatile("s_waitcnt lgkmcnt(0)":::"memory");
    #pragma unroll
    for(int i=0;i<4;++i){const int row=i*8+(lane>>3),ch=lane&7; const u32x4 v=*(const u32x4*)(stg+row*64+ch*8); u32x4 w;
      #pragma unroll
      for(int q=0;q<4;++q){ const float a0=__uint_as_float(v[q]<<16),a1=__uint_as_float(v[q]&0xffff0000u),g0=__uint_as_float(gv[i][q]<<16),g1=__uint_as_float(gv[i][q]&0xffff0000u);
        const float s0=g0*__builtin_amdgcn_rcpf(1.0f+__builtin_amdgcn_exp2f(-1.4426950408889634f*g0)),s1=g1*__builtin_amdgcn_rcpf(1.0f+__builtin_amdgcn_exp2f(-1.4426950408889634f*g1)); w[q]=cvtpk_s(a0*s0,a1*s1); }
      ATTN_STORE16(Ow+(long)row*opitch+ch*8,w);} }
  asm volatile("s_waitcnt lgkmcnt(0)\n\ts_barrier":::"memory");
  #undef DMA_K
  #undef DMA_V
  #undef CMASK
  #undef START
  #undef RESC
  #undef ROT
}
constexpr int ATTN_LDS_BYTES=LDS_BYTES;
#undef SBAR
#undef WAIT_BAR
}
#define GAS __attribute__((address_space(1)))
#define LAS __attribute__((address_space(3)))
#define XB_TMO      128
#define XB_XCNT(j)  (256  + 64 * (j))
#define XB_XSUB(j)  (1280 + 64 * (j))
#define XB_XGEN(j)  (2304 + 64 * (j))
#define XB_TOP      3328
#define XB_TOPGEN   3392
#define XCD_BAR_WORDS 3456
#define XB_SPIN_CAP (1u << 18)

__device__ __forceinline__ unsigned xb_ld(unsigned* p)              { return __hip_atomic_load(p, __ATOMIC_RELAXED, __HIP_MEMORY_SCOPE_AGENT); }
__device__ __forceinline__ unsigned xb_add(unsigned* p, unsigned v) { return __hip_atomic_fetch_add(p, v, __ATOMIC_RELAXED, __HIP_MEMORY_SCOPE_AGENT); }
__device__ __forceinline__ unsigned xb_xcc_id() { return (unsigned)__builtin_amdgcn_s_getreg((3 << 11) | 20) & 0xFu; }
#define XB_SPIN(cond, bar) do { unsigned _sp = 0; while (cond) { __builtin_amdgcn_s_sleep(1); \
    if ((++_sp & 255u) == 0u) { if (xb_ld(&(bar)[XB_TMO])) break; if (_sp > XB_SPIN_CAP) { atomicAdd(&(bar)[XB_TMO], 1u); break; } } } } while (0)

struct XcdBarrier {
    unsigned* bar; unsigned x;
    volatile LAS unsigned* st;
    int wave;
};

__device__ __forceinline__ XcdBarrier xcd_barrier_post(unsigned* bar, volatile LAS unsigned* st, int wave) {
    XcdBarrier b; b.bar = bar; b.x = xb_xcc_id(); b.st = st; b.wave = wave;
    if (wave == 0 && fresh_lane() == 0) (void)xb_add(&bar[XB_XCNT(b.x)], 1u);
    return b;
}
__device__ __forceinline__ void xcd_barrier_complete(unsigned* bar, unsigned x, unsigned& nloc, unsigned& nx) {
    const unsigned G = gridDim.x * gridDim.y * gridDim.z;
    unsigned sum, cnt, mine, sp = 0u;
    for (;;) {
        sum = 0u; cnt = 0u; mine = 0u;
#pragma unroll
        for (unsigned j = 0; j < 16; ++j) { const unsigned c = xb_ld(&bar[XB_XCNT(j)]); sum += c; cnt += (c > 0u) ? 1u : 0u; mine = (j == x) ? c : mine; }
        if (sum == G) break;
        __builtin_amdgcn_s_sleep(1);
        if ((++sp & 255u) == 0u) { if (xb_ld(&bar[XB_TMO])) break; if (sp > XB_SPIN_CAP) { atomicAdd(&bar[XB_TMO], 1u); break; } }
    }
    nloc = mine > 0u ? mine : 1u; nx = cnt > 0u ? cnt : 1u;
}

__device__ __forceinline__ void xcd_barrier(const XcdBarrier& b) {
    asm volatile("s_waitcnt vmcnt(0)" ::: "memory");
    __syncthreads();
    if (b.wave == 0 && fresh_lane() == 0) {
        unsigned* bar = b.bar;
        __builtin_amdgcn_s_waitcnt(0);
        unsigned nloc = b.st[0], nx = b.st[1];
        if (nloc == 0u) { xcd_barrier_complete(bar, b.x, nloc, nx); b.st[0] = nloc; b.st[1] = nx; }
        const unsigned old = xb_add(&bar[XB_XSUB(b.x)], 1u);
        const unsigned gen = old / nloc;
        if (old + 1u == (gen + 1u) * nloc) {
            __builtin_amdgcn_fence(__ATOMIC_RELEASE, "agent");
            asm volatile("s_waitcnt vmcnt(0)" ::: "memory");
            const unsigned og = xb_add(&bar[XB_TOP], 1u);
            const unsigned tg = og / nx;
            if (og + 1u == (tg + 1u) * nx) xb_add(&bar[XB_TOPGEN], 1u);
            else XB_SPIN(xb_ld(&bar[XB_TOPGEN]) == tg, bar);
            __builtin_amdgcn_fence(__ATOMIC_ACQUIRE, "agent");
            xb_add(&bar[XB_XGEN(b.x)], 1u);
            asm volatile("s_waitcnt vmcnt(0)" ::: "memory");
        } else {
            XB_SPIN(xb_ld(&bar[XB_XGEN(b.x)]) == gen, bar);
            __builtin_amdgcn_fence(__ATOMIC_ACQUIRE, "agent");
            asm volatile("s_waitcnt vmcnt(0)" ::: "memory");
        }
    }
    __syncthreads();
}
typedef unsigned short bf16;
typedef unsigned v4u __attribute__((ext_vector_type(4)));
typedef unsigned v2u __attribute__((ext_vector_type(2)));
typedef float f32x4 __attribute__((ext_vector_type(4)));
typedef float f32x16 __attribute__((ext_vector_type(16)));
typedef short bf16x8 __attribute__((ext_vector_type(8)));
constexpr int NWAVES = 8;
constexpr int NB = 32, LSEQ = 2048, LCTX = 256, DM = 1024, NIN = 2816;
constexpr int ROWS_X = NB * LSEQ, ROWS_C = NB * LCTX, MT = ROWS_X + ROWS_C;
constexpr float LN_EPS = 1e-6f;
constexpr size_t MiB = 1u << 20;
constexpr size_t WS_CTL = 0;
constexpr size_t WS_WIN = 1 * MiB;
constexpr size_t WS_WOUT = 12 * MiB;
constexpr size_t WS_PWT = 16 * MiB;
constexpr size_t WS_ROPE = WS_PWT + 65536;
constexpr size_t WS_MOD = WS_PWT + 131072;
constexpr size_t WS_MODP = 17 * MiB;
constexpr size_t WS_HF = 31 * MiB;
constexpr size_t WS_HX = 40 * MiB;
constexpr size_t WS_PX = 184 * MiB;
constexpr size_t WS_KALL = 580 * MiB;
constexpr size_t WS_VALL = 598 * MiB;
constexpr size_t WS_HYT = 616 * MiB;
constexpr size_t WS_HYTC = 680 * MiB;
constexpr size_t WS_YHT = 688 * MiB;
constexpr size_t WS_YHTC = 720 * MiB;
constexpr size_t WS_GY = WS_PX;
constexpr size_t WS_GY0 = 724 * MiB;
constexpr size_t WS_END = 868 * MiB;
constexpr int LDS_BYTES = 163840;
constexpr int STG_OFF = 131072;
constexpr int MISC_OFF = LDS_BYTES - 64;

__device__ __forceinline__ unsigned f2bf(float f) { unsigned u = __builtin_bit_cast(unsigned, f); return (u + 0x7fffu + ((u >> 16) & 1u)) >> 16; }
typedef float f32x2_t __attribute__((ext_vector_type(2))); typedef __bf16 bf16x2_t __attribute__((ext_vector_type(2)));
__device__ __forceinline__ unsigned pk2(float lo, float hi) { f32x2_t v = {lo, hi}; bf16x2_t b = __builtin_convertvector(v, bf16x2_t); return __builtin_bit_cast(unsigned, b); }
__device__ __forceinline__ float bflo(unsigned w) { return __uint_as_float(w << 16); }
__device__ __forceinline__ float bfhi(unsigned w) { return __uint_as_float(w & 0xffff0000u); }
__device__ __forceinline__ float bf1(unsigned short h) { return __uint_as_float(((unsigned)h) << 16); }
__device__ __forceinline__ float rdlane(float v, int l) { return __int_as_float(__builtin_amdgcn_readlane(__float_as_int(v), l)); }
__device__ __forceinline__ float silu(float x) { return x / (1.0f + __expf(-x)); }
__device__ __forceinline__ float silu_fast(float x) { return x * __builtin_amdgcn_rcpf(1.0f + __builtin_amdgcn_exp2f(-1.4426950408889634f * x)); }

struct Frame {
    LAS unsigned char* lds;
    int tid, lane, wave, vcu, G;
    const float* const* in;
    float* out; unsigned char* ws;
};

__device__ __forceinline__ void p0_transpose_item(const float* W, int N, bf16* WT, bool permuted, LAS float* scr, int item, int lane) {
    const int nblk = N / 32, kb = item / nblk, nbp = item % nblk, k0 = 64 * kb, pb = 32 * nbp;
    int lcol = pb + (lane & 31);
    if (permuted) { const int tile = pb >> 8, pc = pb & 255, bj = pc >> 7, wc = (pc >> 5) & 3, q = lane & 31, n = q >> 4, fq = (q >> 2) & 3, e = q & 3;
        if (tile >= 6 && tile <= 8) lcol = tile * 256 + 64 * wc + 32 * (fq >> 1) + 16 * bj + 8 * (fq & 1) + 4 * n + e;
        else lcol = tile * 256 + 128 * bj + 32 * wc + 8 * fq + 4 * n + e; }
#pragma unroll 8
    for (int i = 0; i < 32; ++i) { const int kk = 2 * i + (lane >> 5); scr[kk * 33 + (lane & 31)] = W[(size_t)(k0 + kk) * N + lcol]; }
    asm volatile("s_waitcnt lgkmcnt(0)" ::: "memory");
    const int c = lane & 7;
#pragma unroll
    for (int j = 0; j < 4; ++j) { const int q = (lane >> 3) + 8 * j;
        const LAS float* s = scr + (8 * c) * 33 + q;
        v4u o; o.x = pk2(s[0 * 33], s[1 * 33]); o.y = pk2(s[2 * 33], s[3 * 33]); o.z = pk2(s[4 * 33], s[5 * 33]); o.w = pk2(s[6 * 33], s[7 * 33]);
        *(v4u*)(WT + (size_t)(pb + q) * 1024 + k0 + 8 * c) = o; }
    asm volatile("s_waitcnt lgkmcnt(0)" ::: "memory");
}
constexpr int MOD_KC = 16;
__device__ __forceinline__ void p0_mod_task(const Frame& F, int task, LAS float* scr) {
    const int layer = task / (48 * MOD_KC), rem = task % (48 * MOD_KC), cgp = rem / MOD_KC, kc = rem % MOD_KC, lane = F.lane;
    const int k0 = 64 * kc;
    const float* W = F.in[4] + (size_t)layer * 1024 * 3072 + (size_t)k0 * 3072 + 64 * cgp + lane;
    const float* c = F.in[1]; const float* cc = F.in[3];
#pragma unroll
    for (int kk = 0; kk < 64; kk += 16) { float t[16];
#pragma unroll
        for (int j = 0; j < 16; ++j) t[j] = W[(size_t)(kk + j) * 3072];
#pragma unroll
        for (int j = 0; j < 16; ++j) scr[(kk + j) * 64 + lane] = t[j]; }
    float sv[33], acc[33];
#pragma unroll
    for (int b = 0; b < 32; ++b) sv[b] = c[b * 1024 + k0 + lane];
    sv[32] = cc[k0 + lane];
#pragma unroll
    for (int b = 0; b < 33; ++b) { sv[b] = silu(sv[b]); acc[b] = 0.f; }
    asm volatile("s_waitcnt lgkmcnt(0)" ::: "memory");
#pragma unroll 2
    for (int kk = 0; kk < 64; ++kk) { const float w = scr[kk * 64 + lane];
#pragma unroll
        for (int b = 0; b < 33; ++b) acc[b] = fmaf(rdlane(sv[b], kk), w, acc[b]); }
    float* P = (float*)(F.ws + WS_MODP) + ((size_t)(layer * MOD_KC + kc) * 33) * 3072 + 64 * cgp + lane;
#pragma unroll
    for (int b = 0; b < 33; ++b) P[(size_t)b * 3072] = acc[b];
    asm volatile("s_waitcnt lgkmcnt(0)" ::: "memory");
}
constexpr int FW1 = 0, FW2 = 33 * 64 * 4, FW3 = FW2 + 64 * 64 * 4, FW_END = FW3 + 64 * 512 * 4;
__device__ __forceinline__ void p0_filter_task(const Frame& F, int fidx, int t) {
    const int L = fidx == 2 ? 256 : 2048, layer = fidx == 1 ? 1 : 0, lane = F.lane;
    const LAS float* w1 = (const LAS float*)(F.lds + FW1); const float* b1 = F.in[12] + layer * 64; const float* fq = F.in[13] + layer * 128;
    const LAS float* w2 = (const LAS float*)(F.lds + FW2); const float* b2 = F.in[15] + layer * 64; const LAS float* w3 = (const LAS float*)(F.lds + FW3);
    const float tl = (float)t / (float)(L - 1);
    float z = 0.f;
    if (lane == 0) z = tl;
    else if (lane < 33) { const int j = (lane - 1) & 15; const double frj = 1e-4 + (double)j * ((15.0 - 1e-4) / 15.0);
        double ph = frj * (double)t / (double)L; ph -= floor(ph);
        const float a = (float)(2.0 * ph);
        z = lane < 17 ? cospif(a) : -sinpif(a); }
    float h1 = b1[lane];
    for (int j = 0; j < 33; ++j) h1 = fmaf(rdlane(z, j), w1[j * 64 + lane], h1);
    h1 = sinf(fq[lane] * h1);
    float h2 = b2[lane];
#pragma unroll 8
    for (int m = 0; m < 64; ++m) h2 = fmaf(rdlane(h1, m), w2[m * 64 + lane], h2);
    h2 = sinf(fq[64 + lane] * h2);
    float o[8];
#pragma unroll
    for (int q = 0; q < 8; ++q) o[q] = 0.f;
#pragma unroll 4
    for (int m = 0; m < 64; ++m) { const float hm = rdlane(h2, m);
#pragma unroll
        for (int q = 0; q < 8; ++q) o[q] = fmaf(hm, w3[m * 512 + 64 * q + lane], o[q]); }
    float* HF = (float*)(F.ws + WS_HF) + (fidx == 0 ? 0 : fidx == 1 ? (size_t)512 * 2048 : (size_t)2 * 512 * 2048);
    const float dmin = 3.0701134573253943f, dmax = 15.350567286626972f;
#pragma unroll
    for (int q = 0; q < 8; ++q) { const int cp = 64 * q + lane, ch = cp & 255; const float dl = dmin + (float)ch * ((dmax - dmin) / 255.0f);
        HF[(size_t)cp * L + t] = o[q] * __expf(-tl * dl); }
}
__device__ __forceinline__ void p0a_phase(const Frame& F) {
    const int lane = F.lane;
    { const int half = F.G / 2, wl = F.vcu >= half ? 1 : 0;
      LAS float* L1 = (LAS float*)(F.lds + FW1); LAS float* L2 = (LAS float*)(F.lds + FW2); LAS float* L3 = (LAS float*)(F.lds + FW3);
      const float* g1 = F.in[11] + wl * 33 * 64; const float* g2 = F.in[14] + wl * 64 * 64; const float* g3 = F.in[16] + wl * 64 * 512;
      for (int i = F.tid; i < 33 * 64; i += 512) L1[i] = g1[i];
      for (int i = F.tid; i < 64 * 64; i += 512) L2[i] = g2[i];
      for (int i = F.tid; i < 64 * 512 / 4; i += 512) ((LAS f32x4*)L3)[i] = ((const f32x4*)g3)[i];
      __syncthreads();
      const int nw = half * NWAVES, w0 = (F.vcu - wl * half) * NWAVES + F.wave, ntask = wl ? 2048 : 2304;
      for (int it = w0; it < ntask; it += nw) { if (wl) p0_filter_task(F, 1, it); else if (it < 2048) p0_filter_task(F, 0, it); else p0_filter_task(F, 2, it - 2048); }
      __syncthreads(); }
    LAS float* scr = (LAS float*)(F.lds + F.wave * 16384);
    const int gw = F.vcu * NWAVES + F.wave, NGW = F.G * NWAVES;
    constexpr int T_MOD = 2 * 48 * MOD_KC, T_WIN = 2 * 16 * 88, T_WOUT = 2 * 16 * 32, T_PW = 512, T_ROPE = 16;
    constexpr int NT = T_MOD + T_WIN + T_WOUT + T_PW + T_ROPE;
    for (int it = gw; it < NT; it += NGW) {
        int r = it;
        if (r < T_MOD) { p0_mod_task(F, r, scr); continue; } r -= T_MOD;
        if (r < T_WIN) { const int layer = r / (16 * 88); p0_transpose_item(F.in[6] + (size_t)layer * 1024 * NIN, NIN, (bf16*)(F.ws + WS_WIN) + (size_t)layer * NIN * 1024, true, scr, r % (16 * 88), lane); continue; } r -= T_WIN;
        if (r < T_WOUT) { const int layer = r / (16 * 32); p0_transpose_item(F.in[20] + (size_t)layer * 1024 * 1024, 1024, (bf16*)(F.ws + WS_WOUT) + (size_t)layer * 1024 * 1024, false, scr, r % (16 * 32), lane); continue; } r -= T_WOUT;
        if (r < T_PW) { const int lg = r >> 6, dout = r & 63;
            ((bf16*)(F.ws + WS_PWT))[(size_t)(lg * 64 + dout) * 64 + lane] = (bf16)f2bf(F.in[7][(size_t)(lg * 64 + lane) * 64 + dout]); continue; } r -= T_PW;
        { const int idx = r * 64 + lane, p = idx >> 4, i = idx & 15; const float inv = exp2f(-(float)i * (13.287712379549449f / 16.0f)); const float ang = (float)p * inv;
            float* R = (float*)(F.ws + WS_ROPE); R[2 * idx] = cosf(ang); R[2 * idx + 1] = sinf(ang); }
    }
}
__device__ __forceinline__ void ln_stats(const f32x4 (&v)[4], float& mean, float& rstd) {
    float s = 0.f;
#pragma unroll
    for (int j = 0; j < 4; ++j) s += (v[j][0] + v[j][1]) + (v[j][2] + v[j][3]);
    mean = wave_sum(s) * (1.f / DM); float s2 = 0.f;
#pragma unroll
    for (int j = 0; j < 4; ++j) { const f32x4 d = v[j] - mean; s2 += (d[0] * d[0] + d[1] * d[1]) + (d[2] * d[2] + d[3] * d[3]); }
    rstd = 1.f / sqrtf(wave_sum(s2) * (1.f / DM) + LN_EPS);
}
__device__ __forceinline__ void ln_phase(const Frame& F, int mode) {
    const int gw = F.vcu * NWAVES + F.wave, NGW = F.G * NWAVES, lane = F.lane;
    const int nrows = mode == 2 ? ROWS_X : MT, per = nrows / NGW, ngrp = per / 2, rbase = gw * per;
    bf16* HX = (bf16*)(F.ws + WS_HX); const bf16* GY = (const bf16*)(F.ws + WS_GY0); const bf16* GY1 = (const bf16*)(F.ws + WS_GY);
    const float* MOD = (const float*)(F.ws + WS_MOD); const float* MODP = (const float*)(F.ws + WS_MODP);
    f32x4 sh[4], sc[4], lg[4], lb[4];
    if (mode >= 1) {
#pragma unroll
        for (int j = 0; j < 4; ++j) { const int col = 4 * lane + 256 * j; lg[j] = *(const f32x4*)(F.in[21] + col); lb[j] = *(const f32x4*)(F.in[22] + col); }
    }
    int cur_b = -1;
    LAS float* MS = (LAS float*)F.lds; const int wg_r0 = F.vcu * NWAVES * per, wg_b0 = wg_r0 >= ROWS_X ? 32 : (wg_r0 >> 11);
    if (mode == 0) { const int rl = wg_r0 + NWAVES * per - 1, wg_b1 = rl >= ROWS_X ? 32 : (rl >> 11); const int t4 = 4 * F.tid;
        for (int sl = 0; sl < 2; ++sl) { const int bb = sl == 0 ? wg_b0 : wg_b1; if (sl == 1 && wg_b1 == wg_b0) break;
            f32x4 a = *(const f32x4*)(F.in[5] + t4);
#pragma unroll
            for (int kc = 0; kc < MOD_KC; ++kc) a += *(const f32x4*)(MODP + ((size_t)kc * 33 + bb) * 3072 + t4);
            *(LAS f32x4*)(MS + sl * 2048 + t4) = a; }
        __syncthreads(); }
    f32x4 v[2][4], nv[2][4]; v2u gq[2][4], ngq[2][4], gq1[2][4], ngq1[2][4];
#define LN_SRC(row) ((row) >= ROWS_X ? F.in[2] + (size_t)((row) - ROWS_X) * DM : F.in[0] + (size_t)(row) * DM)
#define LN_LOAD(V, Q, Q1, r0_) do { _Pragma("unroll") for (int rr = 0; rr < 2; ++rr) { const float* src_ = LN_SRC((r0_) + rr); \
        _Pragma("unroll") for (int j = 0; j < 4; ++j) V[rr][j] = __builtin_nontemporal_load((const f32x4*)src_ + lane + 64 * j); \
        if (mode >= 1) { const v2u* gp_ = (const v2u*)(GY + (size_t)((r0_) + rr) * DM) + lane; _Pragma("unroll") for (int j = 0; j < 4; ++j) Q[rr][j] = __builtin_nontemporal_load(gp_ + 64 * j); } \
        if (mode == 2) { const v2u* gp1_ = (const v2u*)(GY1 + (size_t)((r0_) + rr) * DM) + lane; _Pragma("unroll") for (int j = 0; j < 4; ++j) Q1[rr][j] = __builtin_nontemporal_load(gp1_ + 64 * j); } } } while (0)
    LN_LOAD(v, gq, gq1, rbase);
    for (int g = 0; g < ngrp; ++g) {
        const int r0 = rbase + 2 * g; const bool isctx = r0 >= ROWS_X; const int bidx = isctx ? 32 : (r0 >> 11);
        if (g + 1 < ngrp) LN_LOAD(nv, ngq, ngq1, r0 + 2);
        if (mode <= 1 && bidx != cur_b) { cur_b = bidx;
            if (mode == 0) { const LAS float* ms = MS + (bidx == wg_b0 ? 0 : 2048);
#pragma unroll
                for (int j = 0; j < 4; ++j) { const int col = 4 * lane + 256 * j; sh[j] = *(const LAS f32x4*)(ms + col); sc[j] = *(const LAS f32x4*)(ms + 1024 + col); }
            } else {
#pragma unroll
                for (int j = 0; j < 4; ++j) { const int col = 4 * lane + 256 * j; const float* P = MOD + ((size_t)33 + bidx) * 3072 + col; sh[j] = *(const f32x4*)P; sc[j] = *(const f32x4*)(P + 1024); }
            } }
#pragma unroll
        for (int rr = 0; rr < 2; ++rr) {
            const int row = r0 + rr; float mean, rstd;
            if (mode >= 1) {
#pragma unroll
                for (int j = 0; j < 4; ++j) { const v2u q = gq[rr][j]; v[rr][j] = v[rr][j] * 1.4142135623730951f + (f32x4){bflo(q.x), bfhi(q.x), bflo(q.y), bfhi(q.y)}; }
                ln_stats(v[rr], mean, rstd);
#pragma unroll
                for (int j = 0; j < 4; ++j) v[rr][j] = (v[rr][j] - mean) * rstd * lg[j] + lb[j];
            }
            if (mode == 2) {
#pragma unroll
                for (int j = 0; j < 4; ++j) { const v2u q = gq1[rr][j]; v[rr][j] = v[rr][j] * 1.4142135623730951f + (f32x4){bflo(q.x), bfhi(q.x), bflo(q.y), bfhi(q.y)}; }
                ln_stats(v[rr], mean, rstd);
                float* dstf = F.out + (size_t)row * DM;
#pragma unroll
                for (int j = 0; j < 4; ++j) { const int col = 4 * lane + 256 * j + DM; v[rr][j] = (v[rr][j] - mean) * rstd * *(const f32x4*)(F.in[21] + col) + *(const f32x4*)(F.in[22] + col); }
#if MK_CHECK
                if (((const unsigned*)(F.ws + WS_CTL))[3600] != 0u) { const float q_ = __builtin_nanf(""); _Pragma("unroll") for (int j = 0; j < 4; ++j) v[rr][j] = (f32x4){q_, q_, q_, q_}; }
#endif
#pragma unroll
                for (int j = 0; j < 4; ++j) *((f32x4*)dstf + lane + 64 * j) = v[rr][j];
            }
            if (mode <= 1) {
                ln_stats(v[rr], mean, rstd);
                v2u* o8 = (v2u*)(HX + (size_t)row * DM) + lane;
#pragma unroll
                for (int j = 0; j < 4; ++j) { const f32x4 y = (v[rr][j] - mean) * rstd * (sc[j] + 1.0f) + sh[j]; v2u w; w.x = pk2(y[0], y[1]); w.y = pk2(y[2], y[3]); o8[64 * j] = w; }
            }
        }
#pragma unroll
        for (int rr = 0; rr < 2; ++rr)
#pragma unroll
            for (int j = 0; j < 4; ++j) { v[rr][j] = nv[rr][j]; gq[rr][j] = ngq[rr][j]; gq1[rr][j] = ngq1[rr][j]; }
    }
#undef LN_LOAD
#undef LN_SRC
}
__device__ __forceinline__ void mod_finalize(const Frame& F) {
    float* MOD = (float*)(F.ws + WS_MOD); const float* MODP = (const float*)(F.ws + WS_MODP);
    for (int idx = F.vcu * 512 + F.tid; idx < 2 * 33 * 3072; idx += F.G * 512) {
        const int layer = idx / (33 * 3072), rem = idx % (33 * 3072), bidx = rem / 3072, n = rem % 3072;
        float s = F.in[5][layer * 3072 + n];
        for (int kc = 0; kc < MOD_KC; ++kc) s += MODP[((size_t)(layer * MOD_KC + kc) * 33 + bidx) * 3072 + n];
        MOD[idx] = s;
    }
}

template <int L> struct HyLds { static constexpr int CS = 4 * L + 32, U_OFF = 8 * CS, UP = 528, UBUF = 32 * UP, RED_OFF = U_OFF + 2 * UBUF; };
template <int L> __device__ __forceinline__ void hyena_unit(const Frame& F, int c, const float* hf, const float* hb, const bf16* X1, const bf16* V, const float* cw, const float* cb, float hbias, bf16* Y) {
    typedef HyLds<L> H;
    LAS unsigned char* lds = F.lds; const int lane = fresh_lane(), w = F.wave, tid = w * 64 + lane;
    LAS float* Ef = (LAS float*)(lds + H::U_OFF);
    float s = 0.f;
    { constexpr int NK = (2 * L + 8 + 511) / 512; float fa[NK], fb[NK];
#pragma unroll
      for (int k = 0; k < NK; ++k) { const int n = L - (tid + 512 * k); fa[k] = hf[min(max(n, 0), L - 1)]; fb[k] = hb[min(max(-n, 0), L - 1)]; }
#pragma unroll
      for (int k = 0; k < NK; ++k) { const int i = tid + 512 * k, n = L - i;
        const float mf = (n >= 0 && n < L) ? 1.f : 0.f, mb = (n < 0 && n > -L) ? 1.f : 0.f;
        const float gq = fa[k] * mf + fb[k] * mb;
        if (i < 2 * L + 8) Ef[i] = gq;
        s += fabsf(gq); } }
    s = wave_sum(s);
    LAS float* red = (LAS float*)(lds + H::RED_OFF);
    if (lane == 0) red[w] = s;
    __syncthreads();
    float tot = 0.f;
#pragma unroll
    for (int i = 0; i < 8; ++i) tot += red[i];
    const float inv = 1.0f / tot;
#pragma unroll 8
    for (int idx = tid; idx < 8 * 2 * L; idx += 512) { const int sig = idx / (2 * L), i = idx % (2 * L);
        *(LAS unsigned short*)(lds + sig * H::CS + 2 * i) = (unsigned short)f2bf(Ef[i + sig] * inv); }
    __syncthreads();
    const float xa = cw[256 + c], xb = cw[768 + 256 + c], xc = cw[1536 + 256 + c], xbias = cb[256 + c];
    const float va = cw[512 + c], vb = cw[768 + 512 + c], vc = cw[1536 + 512 + c], vbias = cb[512 + c];
    constexpr int TPW = L / 256, NCH = L / 256;
    const int r = lane & 31, h = lane >> 5, tw0 = w * 32 * TPW;
    const int sig = (8 - (r & 7)) & 7, rc8 = (r + 7) >> 3;
    const int abase = sig * H::CS + 2 * (L - 8 * rc8 + 8 * h - tw0);
    f32x16 acc[TPW];
#pragma unroll
    for (int i = 0; i < TPW; ++i) acc[i] = f32x16{};
    const int pb = tid >> 4, seg = tid & 15;
    const unsigned prow = (unsigned)(pb * L + 16 * seg);
    v4u rx0, rx1, rv0, rv1; unsigned short hxm, hxp, hvm, hvp;
#define HY_LOAD(S0) do { const int s_ = (S0) + 16 * seg; const unsigned o_ = prow + (unsigned)(S0); rx0 = *(const v4u*)(X1 + o_); rx1 = *(const v4u*)(X1 + o_ + 8u); rv0 = *(const v4u*)(V + o_); rv1 = *(const v4u*)(V + o_ + 8u); \
        hxm = s_ > 0 ? X1[o_ - 1u] : (unsigned short)0; hvm = s_ > 0 ? V[o_ - 1u] : (unsigned short)0; hxp = s_ + 16 < L ? X1[o_ + 16u] : (unsigned short)0; hvp = s_ + 16 < L ? V[o_ + 16u] : (unsigned short)0; } while (0)
#define HY_PRODUCE(bufi) do { float xv[18], vv[18]; \
            xv[0] = bf1(hxm); vv[0] = bf1(hvm); xv[17] = bf1(hxp); vv[17] = bf1(hvp); \
            _Pragma("unroll") for (int q = 0; q < 4; ++q) { xv[1 + 2 * q] = bflo(rx0[q]); xv[2 + 2 * q] = bfhi(rx0[q]); xv[9 + 2 * q] = bflo(rx1[q]); xv[10 + 2 * q] = bfhi(rx1[q]); \
                                          vv[1 + 2 * q] = bflo(rv0[q]); vv[2 + 2 * q] = bfhi(rv0[q]); vv[9 + 2 * q] = bflo(rv1[q]); vv[10 + 2 * q] = bfhi(rv1[q]); } \
            float u[16]; \
            _Pragma("unroll") for (int j = 0; j < 16; ++j) { const float x1c = xa * xv[j] + xb * xv[j + 1] + xc * xv[j + 2] + xbias, vcv = va * vv[j] + vb * vv[j + 1] + vc * vv[j + 2] + vbias; u[j] = x1c * vcv; } \
            v4u o0, o1; \
            _Pragma("unroll") for (int q = 0; q < 4; ++q) { o0[q] = pk2(u[2 * q], u[2 * q + 1]); o1[q] = pk2(u[8 + 2 * q], u[9 + 2 * q]); } \
            LAS unsigned char* up = lds + H::U_OFF + (bufi) * H::UBUF + pb * H::UP + seg * 32; \
            *(LAS v4u*)up = o0; *(LAS v4u*)(up + 16) = o1; } while (0)
#define HY_MMA(par) do { bf16x8 Ar[8]; \
            if (TPW > 1) { _Pragma("unroll") for (int j = 1; j < 8; ++j) Ar[8 - j] = *(const LAS bf16x8*)(ab + 32 * (par) - 64 * j); } \
            _Pragma("unroll") for (int m = 0; m < 8; ++m) { \
                Ar[m] = *(const LAS bf16x8*)(ab + 64 * m + 32 * (par)); \
                const bf16x8 bfrag = *(const LAS bf16x8*)(ub + 64 * m + 32 * (par)); \
                _Pragma("unroll") for (int i = 0; i < TPW; ++i) acc[i] = __builtin_amdgcn_mfma_f32_32x32x16_bf16(Ar[(m - i) & 7], bfrag, acc[i], 0, 0, 0); } } while (0)
    HY_LOAD(0);
    HY_PRODUCE(0);
    if (NCH > 1) HY_LOAD(256);
    for (int ch = 0; ch < NCH; ++ch) {
        const int S0 = ch * 256, buf = ch & 1;
        __syncthreads();
        const LAS unsigned char* ub = lds + H::U_OFF + buf * H::UBUF + r * H::UP + 16 * h;
        if (ch == tw0 / 256) {
#pragma unroll
            for (int i = 0; i < TPW; ++i)
#pragma unroll
                for (int g4 = 0; g4 < 4; ++g4) { const v2u uu = *(const LAS v2u*)(lds + H::U_OFF + buf * H::UBUF + r * H::UP + 2 * ((tw0 & 255) + 32 * i + 8 * g4 + 4 * h));
                    acc[i][4 * g4] += hbias * bflo(uu.x); acc[i][4 * g4 + 1] += hbias * bfhi(uu.x); acc[i][4 * g4 + 2] += hbias * bflo(uu.y); acc[i][4 * g4 + 3] += hbias * bfhi(uu.y); }
        }
        const LAS unsigned char* ab = lds + abase + 2 * S0;
        HY_MMA(0);
        if (ch + 1 < NCH) { HY_PRODUCE(buf ^ 1); if (ch + 2 < NCH) HY_LOAD(S0 + 512); }
        HY_MMA(1);
    }
#undef HY_PRODUCE
#undef HY_MMA
#undef HY_LOAD
#pragma unroll
    for (int i = 0; i < TPW; ++i)
#pragma unroll
        for (int g = 0; g < 4; ++g) { v2u wv; wv.x = pk2(acc[i][4 * g], acc[i][4 * g + 1]); wv.y = pk2(acc[i][4 * g + 2], acc[i][4 * g + 3]);
            *(v2u*)(Y + (unsigned)(r * L + tw0 + 32 * i + 8 * g + 4 * h)) = wv; }
    __syncthreads();
}
__device__ __forceinline__ void mix_phase(const Frame& F, int layer, int what  ) {
    using attn_body::attn_unit;
    typedef attn_body::bf16 abf;
    const bf16* PX = (const bf16*)(F.ws + WS_PX); bf16* MG = (bf16*)(F.ws + WS_HX);
    const bf16* KA = (const bf16*)(F.ws + WS_KALL); const bf16* VA = (const bf16*)(F.ws + WS_VALL);
    char* shm = (char*)F.lds;
    const int nun = 2048 + (layer == 0 ? 256 : 0);
    if (what & 1) {
        float gqm = 0.f, gkm = 0.f;
        for (int d = 0; d < 64; ++d) { gqm = fmaxf(gqm, fabsf(F.in[18][layer * 64 + d])); gkm = fmaxf(gkm, fabsf(F.in[19][layer * 64 + d])); }
        const bool nomax = 11.55f * gqm * gkm <= 40.0f;
        bool pre = false;
        for (int U = F.vcu; U < nun; U += F.G) {
            const abf *Qp, *Kp, *Vp, *Gp; abf* Op; int nt;
            if (U < 2048) {
                const int bk = U >> 5, rem = U & 31, hq = rem >> 3, qb = rem & 7, b = bk >> 1, kvh = bk & 1, hh = kvh * 4 + hq;
                const size_t row0 = (size_t)b * LSEQ + qb * 256;
                Qp = (const abf*)(PX + row0 * NIN + 1536 + hh * 64); Kp = (const abf*)(KA + (size_t)b * 2304 * 128 + kvh * 64); Vp = (const abf*)(VA + (size_t)b * 2304 * 128 + kvh * 64);
                Op = (abf*)(MG + row0 * DM + 512 + hh * 64); Gp = (const abf*)(PX + row0 * NIN + 2304 + hh * 64); nt = 36;
            } else {
                const int uc = U - 2048, b = uc >> 3, hh = uc & 7, kvh = hh >> 2;
                const size_t row0 = (size_t)ROWS_X + b * LCTX;
                Qp = (const abf*)(PX + row0 * NIN + 1536 + hh * 64); Kp = (const abf*)(KA + ((size_t)b * 2304 + 2048) * 128 + kvh * 64); Vp = (const abf*)(VA + ((size_t)b * 2304 + 2048) * 128 + kvh * 64);
                Op = (abf*)(MG + row0 * DM + 512 + hh * 64); Gp = (const abf*)(PX + row0 * NIN + 2304 + hh * 64); nt = 4;
            }
            const abf *nK = nullptr, *nV = nullptr; const int Un = U + F.G;
            if (nt == 36 && Un < nun) {
                if (Un < 2048) { const int bk = Un >> 5, b = bk >> 1, kvh = bk & 1; nK = (const abf*)(KA + (size_t)b * 2304 * 128 + kvh * 64); nV = (const abf*)(VA + (size_t)b * 2304 * 128 + kvh * 64); }
                else { const int uc = Un - 2048, b = uc >> 3, kvh = (uc & 7) >> 2; nK = (const abf*)(KA + ((size_t)b * 2304 + 2048) * 128 + kvh * 64); nV = (const abf*)(VA + ((size_t)b * 2304 + 2048) * 128 + kvh * 64); }
            }
            if (nomax) { if (nt == 36) attn_unit<8, true>(Qp, NIN, Kp, Vp, 128, 36, Op, DM, Gp, NIN, shm, F.wave, nK, nV, pre); else attn_unit<8, true>(Qp, NIN, Kp, Vp, 128, 4, Op, DM, Gp, NIN, shm, F.wave, nullptr, nullptr, pre); }
            else       { if (nt == 36) attn_unit<8, false>(Qp, NIN, Kp, Vp, 128, 36, Op, DM, Gp, NIN, shm, F.wave, nK, nV, pre); else attn_unit<8, false>(Qp, NIN, Kp, Vp, 128, 4, Op, DM, Gp, NIN, shm, F.wave, nullptr, nullptr, pre); }
            pre = nK != nullptr;
        }
    }
    if (!(what & 2)) return;
    const float* cw = F.in[9] + layer * 3 * 768; const float* cb = F.in[10] + layer * 768;
    for (int c = F.vcu; c < 256; c += F.G) {
        const float* HF = (const float*)(F.ws + WS_HF) + (size_t)layer * 512 * 2048;
        hyena_unit<2048>(F, c, HF + (size_t)c * 2048, HF + (size_t)(256 + c) * 2048, (const bf16*)(F.ws + WS_HYT) + (size_t)c * 32 * 2048, (const bf16*)(F.ws + WS_HYT) + (size_t)(256 + c) * 32 * 2048, cw, cb, F.in[17][layer * 256 + c],
                         (bf16*)(F.ws + WS_YHT) + (size_t)c * 32 * 2048);
        if (layer == 0) {
            const float* HFC = (const float*)(F.ws + WS_HF) + (size_t)2 * 512 * 2048;
            hyena_unit<256>(F, c, HFC + (size_t)c * 256, HFC + (size_t)(256 + c) * 256, (const bf16*)(F.ws + WS_HYTC) + (size_t)c * 32 * 256, (const bf16*)(F.ws + WS_HYTC) + (size_t)(256 + c) * 32 * 256, cw, cb, F.in[17][layer * 256 + c],
                            (bf16*)(F.ws + WS_YHTC) + (size_t)c * 32 * 256);
        }
    }
}

constexpr int MG_VT = 0, MG_P = 528, MG_YL = 50688, MG_WL = 84480;
__device__ __forceinline__ void merge_phase(const Frame& F, int layer, int parts = 3  ) {
    LAS unsigned char* lds = F.lds; const int w = F.wave;
    const bf16* PX = (const bf16*)(F.ws + WS_PX); bf16* MG = (bf16*)(F.ws + WS_HX);
    const bf16* PWT = (const bf16*)(F.ws + WS_PWT) + (size_t)layer * 4 * 64 * 64;
    const float* pscale = F.in[8] + layer * 256; const float* cw = F.in[9] + layer * 3 * 768; const float* cb = F.in[10] + layer * 768; const float* hbias = F.in[17] + layer * 256;
    const int nst = (layer == 0 ? MT : ROWS_X) / 64;
    { LAS float* WL = (LAS float*)(lds + MG_WL); const int tid = F.tid;
      for (int i = tid; i < 3328; i += 512) WL[i] = i < 2304 ? cw[i] : (i < 3072 ? cb[i - 2304] : hbias[i - 3072]); }
    for (int i = F.tid; i < 17 * 33; i += 512) *(LAS v4u*)(lds + MG_VT + (79 + i / 33) * MG_P + 16 * (i % 33)) = (v4u){0u, 0u, 0u, 0u};
    __syncthreads();
    v4u sv[5], yv4[4];
#define MG_STAGE_LOAD(stv) do { const int ln_ = fresh_lane(), td_ = w * 64 + ln_; const int R0_ = (stv) * 64; int b_, t0_, Lq_; unsigned seq0_; const bf16* YH_; \
        if (R0_ < ROWS_X) { b_ = R0_ >> 11; t0_ = R0_ & 2047; Lq_ = LSEQ; seq0_ = (unsigned)(b_ * LSEQ); YH_ = (const bf16*)(F.ws + WS_YHT); } \
        else { const int rc_ = R0_ - ROWS_X; b_ = rc_ >> 8; t0_ = rc_ & 255; Lq_ = LCTX; seq0_ = (unsigned)(ROWS_X + b_ * LCTX); YH_ = (const bf16*)(F.ws + WS_YHTC); } \
        _Pragma("unroll") for (int k = 0; k < 5; ++k) { const int id = td_ + 512 * k, q = id >> 5, ch = id & 31, p = t0_ - 8 + q; \
            sv[k] = (v4u){0u, 0u, 0u, 0u}; if ((parts & 1) && id < 79 * 32 && p >= 0 && p < Lq_) sv[k] = *(const v4u*)(PX + ((seq0_ + (unsigned)p) * (unsigned)NIN + 8u * ch)); } \
        { const int c = td_ >> 1, hs = td_ & 1; const bf16* yp = YH_ + (unsigned)((c * 32 + b_) * Lq_ + t0_ + 32 * hs); \
            _Pragma("unroll") for (int k = 0; k < 4; ++k) yv4[k] = (parts & 2) ? *(const v4u*)(yp + 8 * k) : (v4u){0u, 0u, 0u, 0u}; } } while (0)
    if (F.vcu < nst) MG_STAGE_LOAD(F.vcu);
    for (int st = F.vcu; st < nst; st += F.G) {
        const int lane = fresh_lane(), tid = w * 64 + lane, cg8 = (tid & 31) * 8;
        const int R0 = st * 64; int b, t0, Lq; unsigned seq0;
        if (R0 < ROWS_X) { b = R0 >> 11; t0 = R0 & 2047; Lq = LSEQ; seq0 = (unsigned)(b * LSEQ); }
        else { const int rc = R0 - ROWS_X; b = rc >> 8; t0 = rc & 255; Lq = LCTX; seq0 = (unsigned)(ROWS_X + b * LCTX); }
        (void)seq0; (void)b;
        const int pg_g = w >> 1, pg_dj = w & 1, pg_r = lane & 31, pg_h = lane >> 5;
        v4u x0r[2][3], gr[2];
#define MG_ITEM_LOAD(q) do { const int tok = (tid >> 5) + 16 * (q); const int t = t0 + tok; const unsigned grow = (unsigned)(R0 + tok); \
            const bf16* rowp = PX + (grow * (unsigned)NIN + 512u + cg8); \
            _Pragma("unroll") for (int j = 0; j < 3; ++j) { const bool ok = (t + j - 1 >= 0) && (t + j - 1 < Lq); const bf16* rp = rowp + (j - 1) * NIN; \
                x0r[(q) & 1][j] = ok ? *(const v4u*)rp : (v4u){0u, 0u, 0u, 0u}; } \
            gr[(q) & 1] = *(const v4u*)(rowp + 768); } while (0)
        if (parts & 2) { MG_ITEM_LOAD(0); MG_ITEM_LOAD(1); }
#if 0
        for (int q = 0; q < 4; ++q) { const int tok = (tid >> 5) + 16 * q; const int t = t0 + tok; const unsigned grow = (unsigned)(R0 + tok);
            const bf16* rowp = PX + (grow * (unsigned)NIN + 512u + cg8);
#pragma unroll
            for (int j = 0; j < 3; ++j) { const bool ok = (t + j - 1 >= 0) && (t + j - 1 < Lq); const bf16* rp = rowp + (j - 1) * NIN;
                x0r[q][j] = ok ? *(const v4u*)rp : (v4u){0u, 0u, 0u, 0u}; x1r[q][j] = ok ? *(const v4u*)(rp + 256) : (v4u){0u, 0u, 0u, 0u}; vr[q][j] = ok ? *(const v4u*)(rp + 512) : (v4u){0u, 0u, 0u, 0u}; }
            gr[q] = *(const v4u*)(rowp + 768); }
#endif
#pragma unroll
        for (int k = 0; k < 5; ++k) { const int id = tid + 512 * k, q = id >> 5, ch = id & 31; if (id < 79 * 32) *(LAS v4u*)(lds + MG_VT + q * MG_P + 16 * ch) = sv[k]; }
        { const int c = tid >> 1, hs = tid & 1;
#pragma unroll
            for (int k = 0; k < 4; ++k) {
#pragma unroll
                for (int q = 0; q < 4; ++q) { *(LAS unsigned short*)(lds + MG_YL + (32 * hs + 8 * k + 2 * q) * MG_P + 2 * c) = (unsigned short)(yv4[k][q] & 0xffffu);
                                              *(LAS unsigned short*)(lds + MG_YL + (32 * hs + 8 * k + 2 * q + 1) * MG_P + 2 * c) = (unsigned short)(yv4[k][q] >> 16); } } }
        __syncthreads();
        asm volatile("" ::: "memory");
        v2u pgt[2][4];
#pragma unroll
        for (int jt = 0; jt < 2; ++jt)
#pragma unroll
            for (int G4 = 0; G4 < 4; ++G4) pgt[jt][G4] = *(const v2u*)(PX + ((unsigned)(R0 + 32 * jt + pg_r) * (unsigned)NIN + 256u + 64 * pg_g + 32 * pg_dj + 8 * G4 + 4 * pg_h));
#define MG_ITEM_DO(q) do { const int tok = (tid >> 5) + 16 * (q); const unsigned grow = (unsigned)(R0 + tok); \
            const v4u yr = *(const LAS v4u*)(lds + MG_YL + tok * MG_P + 2 * cg8); v4u o; \
            _Pragma("unroll") for (int hf = 0; hf < 2; ++hf) { \
                const LAS float* WL = (const LAS float*)(lds + MG_WL) + cg8 + 4 * hf; \
                f32x4 a0 = *(const LAS f32x4*)(WL + 2304); \
                _Pragma("unroll") for (int j = 0; j < 3; ++j) { const f32x4 w0 = *(const LAS f32x4*)(WL + j * 768); \
                    const unsigned xa = x0r[(q) & 1][j][2 * hf], xb = x0r[(q) & 1][j][2 * hf + 1]; \
                    a0 += w0 * (f32x4){bflo(xa), bfhi(xa), bflo(xb), bfhi(xb)}; } \
                const unsigned y0 = yr[2 * hf], y1 = yr[2 * hf + 1], g0 = gr[(q) & 1][2 * hf], g1 = gr[(q) & 1][2 * hf + 1]; \
                const f32x4 yv = (f32x4){bflo(y0), bfhi(y0), bflo(y1), bfhi(y1)}, gv = (f32x4){silu_fast(bflo(g0)), silu_fast(bfhi(g0)), silu_fast(bflo(g1)), silu_fast(bfhi(g1))}; \
                const f32x4 res = a0 * yv * gv; \
                o[2 * hf] = pk2(res[0], res[1]); o[2 * hf + 1] = pk2(res[2], res[3]); } \
            asm volatile("" ::: "memory"); \
            *(v4u*)(MG + (grow * (unsigned)DM + 256u + cg8)) = o; } while (0)
        if (st + F.G < nst) MG_STAGE_LOAD(st + F.G);
        if (parts & 2) { MG_ITEM_DO(0); MG_ITEM_LOAD(2); MG_ITEM_DO(1); MG_ITEM_LOAD(3); }
        if (parts & 1) { const int hw = 1 << pg_g;
            bf16x8 bw[4];
#pragma unroll
            for (int kk = 0; kk < 4; ++kk) bw[kk] = *(const bf16x8*)(PWT + ((size_t)pg_g * 64 + 32 * pg_dj + pg_r) * 64 + 16 * kk + 8 * pg_h);
            f32x16 Z[3];
#pragma unroll
            for (int si = 0; si < 3; ++si) { Z[si] = f32x16{};
#pragma unroll
                for (int kk = 0; kk < 4; ++kk) { const bf16x8 a = *(const LAS bf16x8*)(lds + MG_VT + (32 * si + pg_r) * MG_P + 2 * (64 * pg_g + 16 * kk + 8 * pg_h));
                    Z[si] = __builtin_amdgcn_mfma_f32_32x32x16_bf16(a, bw[kk], Z[si], 0, 0, 0); } }
#pragma unroll
            for (int ti = 0; ti < 2; ++ti) {
                const int t = 32 * ti + pg_r, tt = t0 + t; const int lo = max(tt - hw, 0), hi = min(tt + hw, Lq);
                const float rc = __builtin_amdgcn_rcpf((float)(hi - lo)); const int qlo = t + 8 - hw, qhi = t + 8 + hw, qc = t + 8;
                f32x16 acc = f32x16{};
#pragma unroll
                for (int u = 0; u < 3; ++u) { const int ks = 2 * ti + u, si = ks >> 1, sp = ks & 1;
                    v4u zf, mf;
#pragma unroll
                    for (int p = 0; p < 4; ++p) { zf[p] = pk2(Z[si][8 * sp + 2 * p], Z[si][8 * sp + 2 * p + 1]);
                        const int j0 = 2 * p, j1 = 2 * p + 1;
                        const int q0 = 16 * ks + 8 * (j0 >> 2) + 4 * pg_h + (j0 & 3), q1 = 16 * ks + 8 * (j1 >> 2) + 4 * pg_h + (j1 & 3);
                        const float w0 = ((q0 >= qlo && q0 < qhi) ? rc : 0.f) - (q0 == qc ? 1.f : 0.f), w1 = ((q1 >= qlo && q1 < qhi) ? rc : 0.f) - (q1 == qc ? 1.f : 0.f);
                        mf[p] = pk2(w0, w1); }
                    acc = __builtin_amdgcn_mfma_f32_32x32x16_bf16(__builtin_bit_cast(bf16x8, zf), __builtin_bit_cast(bf16x8, mf), acc, 0, 0, 0); }
                const unsigned prow = (unsigned)(R0 + t);
#pragma unroll
                for (int G4 = 0; G4 < 4; ++G4) { const int col = 64 * pg_g + 32 * pg_dj + 8 * G4 + 4 * pg_h;
                    const f32x4 ps = *(const f32x4*)(pscale + col); const v2u gt = pgt[ti][G4];
                    v2u o; o.x = pk2(acc[4 * G4] * ps[0] * silu_fast(bflo(gt.x)), acc[4 * G4 + 1] * ps[1] * silu_fast(bfhi(gt.x))); o.y = pk2(acc[4 * G4 + 2] * ps[2] * silu_fast(bflo(gt.y)), acc[4 * G4 + 3] * ps[3] * silu_fast(bfhi(gt.y)));
                    *(v2u*)(MG + (prow * (unsigned)DM + col)) = o; }
            } }
        if (parts & 2) { MG_ITEM_DO(2); MG_ITEM_DO(3); }
#undef MG_ITEM_DO
#undef MG_ITEM_LOAD
#undef MG_STAGE_LOAD
        __syncthreads();
    }
}
#if MK_CHECK
constexpr int CW_CHKFLAG = 3600;
__device__ __forceinline__ void chk_fail(const Frame& F, int code) { atomicAdd((unsigned*)(F.ws + WS_CTL) + CW_CHKFLAG, 1u); atomicMax((unsigned*)(F.ws + WS_CTL) + CW_CHKFLAG + 1, (unsigned)code); }
__device__ __forceinline__ unsigned hash_u(unsigned x) { x ^= x >> 16; x *= 0x7feb352du; x ^= x >> 15; x *= 0x846ca68bu; x ^= x >> 16; return x; }
__device__ __forceinline__ void check_phase(const Frame& F, int which, int layer) {
    const int gw = F.vcu * NWAVES + F.wave, lane = F.lane;
    const bf16* PX = (const bf16*)(F.ws + WS_PX); const bf16* MG = (const bf16*)(F.ws + WS_HX);
    const bf16* KA = (const bf16*)(F.ws + WS_KALL); const bf16* VA = (const bf16*)(F.ws + WS_VALL);
    const unsigned hsh = hash_u((unsigned)gw * 2654435761u + (unsigned)which * 97u + (unsigned)layer * 31u);
    if (which == 1) {
        const bool isctx = (gw & 1) != 0; if (isctx && layer == 1 && false) return;
        const int b = (hsh >> 3) & 31, t = isctx ? ((hsh >> 8) & 255) : ((hsh >> 8) & 2047), kvh = (hsh >> 20) & 1;
        const size_t row = isctx ? (size_t)ROWS_X + b * LCTX + t : (size_t)b * LSEQ + t;
        const bf16* hx = (const bf16*)(F.ws + WS_HX) + row * DM; const float* W = F.in[6] + (size_t)layer * 1024 * NIN;
        float kd = 0.f, vd = 0.f, pd = 0.f; const int pcol = (hsh >> 22) & 192;
        for (int k = 0; k < 1024; ++k) { const float a = bf1(hx[k]); kd = fmaf(a, W[(size_t)k * NIN + 2048 + 64 * kvh + lane], kd); vd = fmaf(a, W[(size_t)k * NIN + 2176 + 64 * kvh + lane], vd); pd = fmaf(a, W[(size_t)k * NIN + pcol + lane], pd); }
        const float rs = 1.0f / sqrtf(wave_sum(kd * kd) * (1.0f / 64.0f) + 1e-6f);
        float kn = kd * rs * F.in[19][layer * 64 + lane];
        if (!isctx) {
            const int g = lane >> 5, i = lane & 15, pos = g == 0 ? (t >> 6) : (t & 63); const float inv = exp2f(-(float)i * (13.287712379549449f / 16.0f)); const float ang = (float)pos * inv, cs = cosf(ang), sn = sinf(ang);
            const float other = __shfl_xor(kn, 16); kn = ((lane >> 4) & 1) ? (other * sn + kn * cs) : (kn * cs - other * sn); }
        const size_t kvrow = ((size_t)b * 2304 + (isctx ? 2048 + t : t)) * 128 + 64 * kvh + lane;
        const float ka = bf1(KA[kvrow]), va = bf1(VA[kvrow]);
        if (fabsf(ka - kn) > 0.02f * fabsf(kn) + 0.02f) chk_fail(F, 10 + layer);
        if (fabsf(va - vd) > 0.02f * fabsf(vd) + 0.02f) chk_fail(F, 12 + layer);
        if (!(isctx && layer == 1)) {
            const int hq = (hsh >> 26) & 7; float qd = 0.f;
            for (int k = 0; k < 1024; ++k) qd = fmaf(bf1(hx[k]), W[(size_t)k * NIN + 1536 + 64 * hq + lane], qd);
            const float rq = 1.0f / sqrtf(wave_sum(qd * qd) * (1.0f / 64.0f) + 1e-6f);
            float qn = qd * rq * F.in[18][layer * 64 + lane];
            if (!isctx) { const int g = lane >> 5, i = lane & 15, pos = g == 0 ? (t >> 6) : (t & 63); const float inv = exp2f(-(float)i * (13.287712379549449f / 16.0f)); const float ang = (float)pos * inv, cs = cosf(ang), sn = sinf(ang);
                const float other = __shfl_xor(qn, 16); qn = ((lane >> 4) & 1) ? (other * sn + qn * cs) : (qn * cs - other * sn); }
            qn *= 0.125f * 1.4426950408889634f;
            const float qa = bf1(PX[row * NIN + 1536 + 64 * hq + lane]);
            if (fabsf(qa - qn) > 0.02f * fabsf(qn) + 0.004f) chk_fail(F, 16 + layer); }
        if (!(isctx && layer == 1)) { const float pa = bf1(PX[row * NIN + pcol + lane]); if (fabsf(pa - pd) > 0.02f * fabsf(pd) + 0.02f) chk_fail(F, 14 + layer); }
    } else if (which == 2) {
        if ((gw & 1) == 0) {
            const bool isctx = layer == 0 && (gw & 6) == 0;
            const int b = (hsh >> 3) & 31, t = isctx ? ((hsh >> 8) & 255) : ((hsh >> 8) & 2047), hh = (hsh >> 20) & 7, kvh = hh >> 2;
            const size_t row = isctx ? (size_t)ROWS_X + b * LCTX + t : (size_t)b * LSEQ + t;
            const int j0 = isctx ? 2048 : 0, nk = isctx ? 256 : 2304;
            const float qd = bf1(PX[row * NIN + 1536 + 64 * hh + lane]);
            float m = -1e30f, l = 0.f, o = 0.f;
            for (int j = 0; j < nk; ++j) { const size_t kr = ((size_t)b * 2304 + j0 + j) * 128 + 64 * kvh + lane;
                const float s = wave_sum(qd * bf1(KA[kr])), mn = fmaxf(m, s), f = exp2f(m - mn), p = exp2f(s - mn);
                o = o * f + p * bf1(VA[kr]); l = l * f + p; m = mn; }
            const float mine = o;
            const float gt_ = bf1(PX[row * NIN + 2304 + 64 * hh + lane]);
            const float ref = mine / l * (gt_ / (1.0f + __expf(-gt_))), act = bf1(MG[row * DM + 512 + 64 * hh + lane]);
            if (fabsf(act - ref) > 0.03f * fabsf(ref) + 0.002f) chk_fail(F, 20 + layer + (isctx ? 2 : 0));
        } else {
            const bool isctx = layer == 0 && (gw & 6) == 0; const int L = isctx ? 256 : 2048;
            const int c = (hsh >> 3) & 255, b = (hsh >> 11) & 31, t = (hsh >> 16) & (L - 1);
            const float* HF = (const float*)(F.ws + WS_HF) + (isctx ? (size_t)2 * 512 * 2048 : (size_t)layer * 512 * 2048);
            const float* hf = HF + (size_t)c * L; const float* hb = HF + (size_t)(256 + c) * L;
            float nrm = 0.f; for (int i = lane; i < L; i += 64) { nrm += fabsf(hf[i]); if (i > 0) nrm += fabsf(hb[i]); }
            nrm = wave_sum(nrm);
            const float* cw = F.in[9] + layer * 3 * 768; const float* cb = F.in[10] + layer * 768;
            const bf16* XT = isctx ? (const bf16*)(F.ws + WS_HYTC) : (const bf16*)(F.ws + WS_HYT);
            float acc = 0.f;
            for (int s = lane; s < L; s += 64) { float x1c = cb[256 + c], vc = cb[512 + c];
                for (int j = 0; j < 3; ++j) { const int ss = s + j - 1; if (ss >= 0 && ss < L) { x1c = fmaf(cw[j * 768 + 256 + c], bf1(XT[((size_t)c * 32 + b) * L + ss]), x1c); vc = fmaf(cw[j * 768 + 512 + c], bf1(XT[((size_t)(256 + c) * 32 + b) * L + ss]), vc); } }
                if (s == t) acc = fmaf(x1c * vc, nrm * F.in[17][layer * 256 + c], acc);
                const int n = t - s; const float g = n >= 0 ? hf[n] : hb[-n]; acc = fmaf(x1c * vc, g, acc); }
            const float ref = wave_sum(acc) / nrm;
            const bf16* YH = isctx ? (const bf16*)(F.ws + WS_YHTC) : (const bf16*)(F.ws + WS_YHT);
            const float act = bf1(YH[((size_t)c * 32 + b) * L + t]);
            if (lane == 0 && fabsf(act - ref) > 0.02f * fabsf(ref) + 0.0007f) chk_fail(F, 30 + layer + (isctx ? 2 : 0));
        }
    } else if (which == 3) {
        const bool isctx = layer == 0 && (gw & 3) == 0; const int L = isctx ? 256 : 2048;
        const int b = (hsh >> 3) & 31, t = (gw & 4) ? ((hsh >> 8) & 15) * ((gw & 8) ? 1 : -1) + ((gw & 8) ? 0 : L - 1) : ((hsh >> 8) & (L - 1));
        const size_t seq0 = isctx ? (size_t)ROWS_X + b * LCTX : (size_t)b * LSEQ, row = seq0 + t;
#ifndef CHK3
#define CHK3 0xff
#endif
        if (!(CHK3 & 4) && isctx) return; if (!(CHK3 & 8) && !isctx) return; if (!(CHK3 & 16) && (gw & 4)) return; if (!(CHK3 & 32) && !(gw & 4)) return;
        if ((gw & 16) && !(CHK3 & 1)) return; if (!(gw & 16) && !(CHK3 & 2)) return;
        if (gw & 16) {
            const int g = (hsh >> 24) & 3, hw = 1 << g, lo = max(t - hw, 0), hi = min(t + hw, L);
            float m = 0.f; for (int p = lo; p < hi; ++p) m += bf1(PX[(seq0 + p) * NIN + 64 * g + lane]);
            const float d = m / (float)(hi - lo) - bf1(PX[row * NIN + 64 * g + lane]);
            const float* pw = F.in[7] + (size_t)(layer * 4 + g) * 64 * 64;
            float mine = 0.f;
            for (int dout = 0; dout < 64; ++dout) { const float y = wave_sum(d * pw[lane * 64 + dout]); if (dout == lane) mine = y; }
            const float pg_ = bf1(PX[row * NIN + 256 + 64 * g + lane]);
            const float ref = mine * F.in[8][layer * 256 + 64 * g + lane] * (pg_ / (1.0f + __expf(-pg_))), act = bf1(MG[row * DM + 64 * g + lane]);
            if (fabsf(act - ref) > 0.03f * fabsf(ref) + 0.03f) chk_fail(F, 40 + layer + (isctx ? 2 : 0));
        } else {
            const int c = ((hsh >> 24) & 3) * 64 + lane;
            const float* cw = F.in[9] + layer * 3 * 768; const float* cb = F.in[10] + layer * 768;
            float a0 = cb[c];
            for (int j = 0; j < 3; ++j) { const int ss = t + j - 1; if (ss >= 0 && ss < L) { const bf16* rp = PX + (seq0 + ss) * NIN; a0 = fmaf(cw[j * 768 + c], bf1(rp[512 + c]), a0); } }
            const bf16* YH = isctx ? (const bf16*)(F.ws + WS_YHTC) : (const bf16*)(F.ws + WS_YHT);
            const float y = bf1(YH[((size_t)c * 32 + b) * L + t]);
            const float hg_ = bf1(PX[row * NIN + 1280 + c]);
            const float ref = a0 * y * (hg_ / (1.0f + __expf(-hg_))), act = bf1(MG[row * DM + 256 + c]);
            if (fabsf(act - ref) > 0.02f * fabsf(ref) + 0.01f) chk_fail(F, 44 + layer + (isctx ? 2 : 0));
        }
    } else if (which == 4) {
        if (gw >= 64) return;
        const bool isctx = layer == 0 && (gw & 1) != 0;
        const int b = (hsh >> 3) & 31, t = isctx ? ((hsh >> 8) & 255) : ((hsh >> 8) & 2047);
        const size_t row = isctx ? (size_t)ROWS_X + b * LCTX + t : (size_t)b * LSEQ + t;
        const float* W = F.in[20] + (size_t)layer * 1024 * 1024; const bf16* mrow = MG + row * DM;
        f32x4 acc[4] = {};
        for (int k = 0; k < 1024; ++k) { const float a = bf1(mrow[k]);
#pragma unroll
            for (int j = 0; j < 4; ++j) acc[j] += *(const f32x4*)(W + (size_t)k * 1024 + 4 * lane + 256 * j) * a; }
        const float* gate = (const float*)(F.ws + WS_MOD) + ((size_t)layer * 33 + (isctx ? 32 : b)) * 3072 + 2048;
        const bf16* gy = (const bf16*)(F.ws + (layer == 0 ? WS_GY0 : WS_GY)) + row * DM;
#pragma unroll
        for (int j = 0; j < 4; ++j)
#pragma unroll
            for (int e = 0; e < 4; ++e) { const int col = 4 * lane + 256 * j + e; const float ref = acc[j][e] * gate[col], act = bf1(gy[col]); if (fabsf(act - ref) > 0.02f * fabsf(ref) + 0.004f) chk_fail(F, 50 + layer + (isctx ? 2 : 0)); }
    } else if (which == 5) {
        const bool isctx = (gw & 1) != 0;
        const int b = (hsh >> 3) & 31, t = isctx ? ((hsh >> 8) & 255) : ((hsh >> 8) & 2047);
        const size_t row = isctx ? (size_t)ROWS_X + b * LCTX + t : (size_t)b * LSEQ + t;
        const float* src = isctx ? F.in[2] + (row - ROWS_X) * DM : F.in[0] + row * DM; const bf16* gy = (const bf16*)(F.ws + WS_GY0) + row * DM;
        const float* MOD1 = (const float*)(F.ws + WS_MOD) + ((size_t)33 + (isctx ? 32 : b)) * 3072;
        float v[16]; float s = 0.f;
#pragma unroll
        for (int i = 0; i < 16; ++i) { const int col = lane + 64 * i; v[i] = 1.4142135623730951f * src[col] + bf1(gy[col]); s += v[i]; }
        float mean = wave_sum(s) * (1.f / DM), s2 = 0.f;
#pragma unroll
        for (int i = 0; i < 16; ++i) { v[i] -= mean; s2 += v[i] * v[i]; }
        float rstd = 1.f / sqrtf(wave_sum(s2) * (1.f / DM) + LN_EPS); s = 0.f;
#pragma unroll
        for (int i = 0; i < 16; ++i) { const int col = lane + 64 * i; v[i] = v[i] * rstd * F.in[21][col] + F.in[22][col]; s += v[i];
            }
        mean = wave_sum(s) * (1.f / DM); s2 = 0.f;
#pragma unroll
        for (int i = 0; i < 16; ++i) { v[i] -= mean; s2 += v[i] * v[i]; }
        rstd = 1.f / sqrtf(wave_sum(s2) * (1.f / DM) + LN_EPS);
#pragma unroll
        for (int i = 0; i < 16; ++i) { const int col = lane + 64 * i; const float ref = v[i] * rstd * (1.f + MOD1[1024 + col]) + MOD1[col], act = bf1(((const bf16*)(F.ws + WS_HX))[row * DM + col]);
            if (fabsf(act - ref) > 0.01f * fabsf(ref) + 0.01f) chk_fail(F, 62 + (isctx ? 1 : 0)); }
    }
}
#endif
#ifndef MK_MULTI
#define MK_MULTI 0
#endif
struct Args { const float* in[23]; float* out; unsigned char* ws; int ph_lo, ph_hi; };
constexpr int N_PHASES = 12;

__global__ void __launch_bounds__(NWAVES * 64, 2) mega_fwd(Args args) {
    extern __shared__ __attribute__((aligned(16))) unsigned char lds_raw[];
    Frame F;
    F.lds = (LAS unsigned char*)lds_raw;
    F.G = gridDim.x; { const int bx = blockIdx.x; F.vcu = (F.G % 8 == 0) ? (bx % 8) * (F.G / 8) + bx / 8 : bx; }
    F.in = args.in;
    F.wave = __builtin_amdgcn_readfirstlane((int)threadIdx.x >> 6);
    const int lo = args.ph_lo, hi = args.ph_hi;
#if MK_MULTI
#define GRID_SYNC() do { } while (0)
#define GRID_SYNC_CG() do { } while (0)
#else
    volatile LAS unsigned* misc = (volatile LAS unsigned*)(F.lds + MISC_OFF);
    { const int l_ = fresh_lane(); if (F.wave == 0 && l_ < 16) misc[l_] = 0u; }
    __syncthreads();
    XcdBarrier bar = xcd_barrier_post((unsigned*)(args.ws + WS_CTL), misc, F.wave);
#define GRID_SYNC() xcd_barrier(bar)
#define GRID_SYNC_CG() do { __threadfence(); cg::this_grid().sync(); } while (0)
#endif
#ifndef PH_MASK
#define PH_MASK 0xfff
#endif
#define PH_ON(k) ((PH_MASK >> (k)) & 1)
#ifndef DUP_MASK
#define DUP_MASK 0
#endif
#define DUP(k) ((DUP_MASK >> (k)) & 1)
#define IN(k) (lo <= (k) && (k) < hi)
#ifndef SEAM0_CG
#define SEAM0_CG 0
#endif
#define SEAM(k) do { if (IN(k) && IN((k) + 1)) { if (SEAM0_CG && (k) == 0) GRID_SYNC_CG(); else GRID_SYNC(); } } while (0)
#define FRESH() do { F.lane = fresh_lane(); F.tid = F.wave * 64 + F.lane; F.ws = args.ws; F.out = args.out; } while (0)
    if (IN(0) && PH_ON(0)) { FRESH(); p0a_phase(F); if (DUP(0)) { __syncthreads(); p0a_phase(F); } }
    SEAM(0);
    if (IN(1) && PH_ON(1)) { FRESH(); mod_finalize(F); ln_phase(F, 0); if (DUP(1)) ln_phase(F, 0); }
    SEAM(1);
#pragma unroll 1
    for (int layer = 0; layer < 2; ++layer) {
        const int p0 = 2 + 5 * layer;
        if (IN(p0) && PH_ON(2)) { FRESH();
            pg8::Gemm g{(const pg8::bf16_t*)(F.ws + WS_HX), (const pg8::bf16_t*)(F.ws + WS_WIN) + (size_t)layer * NIN * 1024, MT, NIN, DM};
            pg8::GridOrder S;
            if (layer == 0) S = pg8::GridOrder{MT / 256, NIN / 256, 0, 0, 0, F.G, (int)blockIdx.x};
            else S = pg8::GridOrder{ROWS_X / 256, NIN / 256, ROWS_C / 256, ROWS_X / 256, 8, F.G, (int)blockIdx.x};
            pg8::EpiIn E{(pg8::bf16_t*)(F.ws + WS_PX), (pg8::bf16_t*)(F.ws + WS_KALL), (pg8::bf16_t*)(F.ws + WS_VALL), (pg8::bf16_t*)(F.ws + WS_HYT), (pg8::bf16_t*)(F.ws + WS_HYTC),
                          F.in[18] + layer * 64, F.in[19] + layer * 64, (const float*)(F.ws + WS_ROPE), F.lds + STG_OFF};
#ifdef DUP_DUMMY
            { pg8::EpiDummy ED{(pg8::bf16_t*)(F.ws + WS_PX), NIN}; pg8::gemm_phase<pg8::EpiDummy, pg8::GridOrder, true, true>(F.lds, g, S, ED, F.wave); __syncthreads(); }
#endif
            pg8::gemm_phase<pg8::EpiIn, pg8::GridOrder, true, true>(F.lds, g, S, E, F.wave);
            if (DUP(2)) { __syncthreads(); pg8::gemm_phase<pg8::EpiIn, pg8::GridOrder, true, true>(F.lds, g, S, E, F.wave); }
#ifdef DUP_PN
            if (layer == 0) { __syncthreads(); pg8::GridOrder S2{0, NIN / 256, MT / 256, 0, DUP_PN, F.G, (int)blockIdx.x}; pg8::gemm_phase<pg8::EpiIn, pg8::GridOrder, true, true>(F.lds, g, S2, E, F.wave); }
#endif
            }
        SEAM(p0);
#if MK_CHECK
        if (MK_CHECK & 1) { FRESH(); check_phase(F, 1, layer); GRID_SYNC(); }
#endif
        if (IN(p0 + 1) && PH_ON(3)) { FRESH(); mix_phase(F, layer, 3); if (DUP(3)) mix_phase(F, layer, 1); if (DUP(7)) mix_phase(F, layer, 2); }
        SEAM(p0 + 1);
#if MK_CHECK
        if (MK_CHECK & 2) { FRESH(); check_phase(F, 2, layer); GRID_SYNC(); }
#endif
        if (IN(p0 + 2) && PH_ON(4)) { FRESH(); merge_phase(F, layer); if (DUP(4)) merge_phase(F, layer); if (DUP(8)) merge_phase(F, layer, 1); if (DUP(9)) merge_phase(F, layer, 2); }
        SEAM(p0 + 2);
#if MK_CHECK
        if (MK_CHECK & 4) { FRESH(); check_phase(F, 3, layer); GRID_SYNC(); }
#endif
        if (IN(p0 + 3) && PH_ON(5)) { FRESH();
            pg8::Gemm g{(const pg8::bf16_t*)(F.ws + WS_HX), (const pg8::bf16_t*)(F.ws + WS_WOUT) + (size_t)layer * 1024 * 1024, MT, DM, DM};
            pg8::GridOrder S{(layer == 0 ? MT : ROWS_X) / 256, DM / 256, 0, 0, 0, F.G, (int)blockIdx.x};
            pg8::EpiOut E{(pg8::bf16_t*)(F.ws + (layer == 0 ? WS_GY0 : WS_GY)), (const float*)(F.ws + WS_MOD) + (size_t)layer * 33 * 3072};
            pg8::gemm_phase<pg8::EpiOut, pg8::GridOrder, true, true>(F.lds, g, S, E, F.wave);
            if (DUP(5)) { __syncthreads(); pg8::gemm_phase<pg8::EpiOut, pg8::GridOrder, true, true>(F.lds, g, S, E, F.wave); } }
        SEAM(p0 + 3);
#if MK_CHECK
        if (MK_CHECK & 8) { FRESH(); check_phase(F, 4, layer); GRID_SYNC(); }
#endif
        if (IN(p0 + 4) && PH_ON(6)) { FRESH(); ln_phase(F, layer + 1); }
        SEAM(p0 + 4);
#if MK_CHECK
        if ((MK_CHECK & 16) && layer == 0) { FRESH(); check_phase(F, 5, layer); GRID_SYNC(); }
#endif
    }
#undef IN
#undef SEAM
#undef FRESH
}

extern "C" void kernel_launch(void* const* d_in, const int* in_sizes, int n_in, void* d_out, int out_size, void* d_ws, size_t ws_size, hipStream_t stream) {
    static int grid = 0;
    if (grid == 0) {
        if (n_in != 23 || out_size != ROWS_X * DM || ws_size < WS_END) { fprintf(stderr, "kernel_launch: unexpected shapes (n_in %d, out %d, ws %zu)\n", n_in, out_size, ws_size); grid = -1; return; }
        int dev = 0, cus = 0, per_cu = 0;
        hipGetDevice(&dev); hipDeviceGetAttribute(&cus, hipDeviceAttributeMultiprocessorCount, dev);
        hipFuncSetAttribute((const void*)mega_fwd, hipFuncAttributeMaxDynamicSharedMemorySize, LDS_BYTES);
        hipOccupancyMaxActiveBlocksPerMultiprocessor(&per_cu, (const void*)mega_fwd, NWAVES * 64, LDS_BYTES);
        (void)hipGetLastError();
        if (per_cu < 1) { fprintf(stderr, "kernel_launch: occupancy query reports %d blocks per CU\n", per_cu); per_cu = 1; }
        grid = 256; while (grid > cus) grid >>= 1;
    }
    if (grid < 0) return;
#if !MK_MULTI
    if (hipMemsetAsync((char*)d_ws + WS_CTL, 0, 16384, stream) != hipSuccess) { fprintf(stderr, "kernel_launch: memset of the barrier words failed\n"); return; }
#endif
    Args a{};
    for (int i = 0; i < 23; ++i) a.in[i] = (const float*)d_in[i];
    a.out = (float*)d_out; a.ws = (unsigned char*)d_ws;
#if MK_MULTI
    for (int ph = 0; ph < N_PHASES; ++ph) { a.ph_lo = ph; a.ph_hi = ph + 1; hipLaunchKernelGGL(mega_fwd, dim3(grid), dim3(NWAVES * 64), LDS_BYTES, stream, a); }
#else
    a.ph_lo = 0; a.ph_hi = N_PHASES;
    void* kargs[] = {&a};
    hipError_t e = hipLaunchCooperativeKernel((const void*)mega_fwd, dim3(grid), dim3(NWAVES * 64), kargs, LDS_BYTES, stream);
    if (e != hipSuccess) fprintf(stderr, "cooperative launch failed: %s (grid %d)\n", hipGetErrorString(e), grid);
#endif
}
```
